# Optimizing an MI355X kernel written in HIP

```python
import jax, jax.numpy as jnp
from jax import lax
import numpy as np

D_MODEL = 1024
BATCH = 8
SEQ = 2048
DEPTH = 2

GRID_W = 64
CTX_LEN = 256
N_MIXERS = 2
N_MOD = 6
NORM_EPS = 1e-6
CHUNK = 128
GM_WIDTH = 2 * D_MODEL
GM_GROUPS = 8
HEAD_DIM = 128
N_Q_HEADS = D_MODEL // HEAD_DIM
N_KV_HEADS = 2
GQA_GROUP = N_Q_HEADS // N_KV_HEADS
AXIS_DIM = HEAD_DIM // 2
ROPE_THETA = 10000.0
Q_BLOCK = 128
N_EXPERTS = 32
TOP_K = 4
D_EXPERT = D_MODEL
SWIGLU_LIMIT = 7.0
SWIGLU_ALPHA = 1.702
EXPERT_BLOCK = 128
N_A_LAYERS = (DEPTH + 1) // 2
N_B_LAYERS = DEPTH // 2

kernel_name = 'hybrid_gmlp_gqa_moe_diffusion_trunk'


def rmsnorm(x, gain):
    xf = x.astype(jnp.float32)
    y = xf * lax.rsqrt(jnp.mean(xf * xf, axis=-1, keepdims=True) + NORM_EPS)
    return (y * gain.astype(jnp.float32)).astype(x.dtype)


def modulate(h, shift, scale):
    return h * (1 + scale) + shift


def axial_rope_tables(rows):
    row = jnp.repeat(jnp.arange(rows, dtype=jnp.int32), GRID_W).astype(jnp.float32)
    col = jnp.tile(jnp.arange(GRID_W, dtype=jnp.int32), rows).astype(jnp.float32)
    inv_freq = 1.0 / (ROPE_THETA ** (jnp.arange(0, AXIS_DIM, 2, dtype=jnp.float32) / AXIS_DIM))
    ang = jnp.stack([row[:, None] * inv_freq, col[:, None] * inv_freq], axis=0)
    return jnp.cos(ang), jnp.sin(ang)


def apply_axial_rope(x, cos, sin):
    xr = x.reshape(*x.shape[:-1], 2, 2, AXIS_DIM // 2)
    x1, x2 = xr[..., 0, :], xr[..., 1, :]
    cs = jnp.transpose(cos, (1, 0, 2))[None, :, None].astype(x.dtype)
    sn = jnp.transpose(sin, (1, 0, 2))[None, :, None].astype(x.dtype)
    out = jnp.stack([x1 * cs - x2 * sn, x2 * cs + x1 * sn], axis=-2)
    return out.reshape(x.shape)


def chunk_gmlp(h, w_in, b_in, v_gain, w_s, b_s, w_out):
    B_, L, _ = h.shape
    uv = jax.nn.gelu(h @ w_in + b_in, approximate=False)
    u, v = jnp.split(uv, 2, axis=-1)
    v = rmsnorm(v, v_gain)
    v = v.reshape(B_, L // CHUNK, CHUNK, GM_GROUPS, GM_WIDTH // GM_GROUPS)
    s = jnp.einsum('gpq,bnqgc->bnpgc', w_s, v) + b_s.T[:, :, None]
    return (u * s.reshape(B_, L, GM_WIDTH)) @ w_out


def qkv_heads(h, w_qkv, q_gain, k_gain):
    B_, L, _ = h.shape
    qkv = h @ w_qkv
    q, k, v = jnp.split(qkv, [N_Q_HEADS * HEAD_DIM, (N_Q_HEADS + N_KV_HEADS) * HEAD_DIM], axis=-1)
    q = rmsnorm(q.reshape(B_, L, N_Q_HEADS, HEAD_DIM), q_gain)
    k = rmsnorm(k.reshape(B_, L, N_KV_HEADS, HEAD_DIM), k_gain)
    v = v.reshape(B_, L, N_KV_HEADS, HEAD_DIM)
    return q, k, v


def attend(q, k, v):
    B_, Lq = q.shape[:2]
    qg = q.reshape(B_, Lq, N_KV_HEADS, GQA_GROUP, HEAD_DIM)
    s = jnp.einsum('bqkgd,bskd->bkgqs', qg, k).astype(jnp.float32) * (HEAD_DIM ** -0.5)
    p = jax.nn.softmax(s, axis=-1).astype(v.dtype)
    o = jnp.einsum('bkgqs,bskd->bqkgd', p, v)
    return o.reshape(B_, Lq, N_Q_HEADS * HEAD_DIM)


def gqa_mixer(h_lat, h_ctx, w_qkv, q_gain, k_gain, w_o, cos, sin, with_ctx_out):
    B_, L, _ = h_lat.shape
    q_l, k_l, v_l = qkv_heads(h_lat, w_qkv, q_gain, k_gain)
    q_l = apply_axial_rope(q_l, cos, sin)
    k_l = apply_axial_rope(k_l, cos, sin)
    q_c, k_c, v_c = qkv_heads(h_ctx, w_qkv, q_gain, k_gain)
    k_all = jnp.concatenate([k_c, k_l], axis=1)
    v_all = jnp.concatenate([v_c, v_l], axis=1)
    nb = L // Q_BLOCK
    q_blocks = jnp.moveaxis(q_l.reshape(B_, nb, Q_BLOCK, N_Q_HEADS, HEAD_DIM), 1, 0)
    o = lax.map(lambda qb: attend(qb, k_all, v_all), q_blocks)
    o_lat = jnp.moveaxis(o, 0, 1).reshape(B_, L, N_Q_HEADS * HEAD_DIM) @ w_o
    if with_ctx_out:
        o_ctx = attend(q_c, k_c, v_c) @ w_o
        return o_lat, o_ctx
    return o_lat, None


def moe_ffn(h, router_w, router_b, w_gu, b_gu, w_down, b_down):
    T, D = h.shape
    logits = (h @ router_w + router_b).astype(jnp.float32)
    top_val, top_idx = lax.top_k(logits, TOP_K)
    gates = jax.nn.softmax(top_val, axis=-1)
    n_assign = T * TOP_K
    flat_e = top_idx.reshape(-1)
    order = jnp.argsort(flat_e, stable=True)
    sorted_e = flat_e[order]
    tok = (order // TOP_K).astype(jnp.int32)
    gate_sorted = gates.reshape(-1)[order]
    counts = jnp.bincount(flat_e, length=N_EXPERTS)
    padded = (counts + EXPERT_BLOCK - 1) // EXPERT_BLOCK * EXPERT_BLOCK
    pad_end = jnp.cumsum(padded)
    pad_start = pad_end - padded
    grp_start = jnp.cumsum(counts) - counts
    dest = pad_start[sorted_e] + jnp.arange(n_assign, dtype=jnp.int32) - grp_start[sorted_e]
    n_blocks = -(-n_assign // EXPERT_BLOCK) + N_EXPERTS
    cap = n_blocks * EXPERT_BLOCK
    buf_tok = jnp.full((cap,), T, jnp.int32).at[dest].set(tok)
    buf_gate = jnp.zeros((cap,), jnp.float32).at[dest].set(gate_sorted)
    block_expert = jnp.minimum(
        jnp.searchsorted(pad_end, jnp.arange(n_blocks, dtype=jnp.int32) * EXPERT_BLOCK, side='right'),
        N_EXPERTS - 1)
    h_pad = jnp.concatenate([h, jnp.zeros((1, D), h.dtype)], axis=0)
    xb = h_pad[buf_tok].reshape(n_blocks, EXPERT_BLOCK, D)

    def expert_block(args):
        xblk, e = args
        gu = xblk @ w_gu[e] + b_gu[e]
        g, u = jnp.split(gu, 2, axis=-1)
        g = jnp.minimum(g, SWIGLU_LIMIT)
        u = jnp.clip(u, -SWIGLU_LIMIT, SWIGLU_LIMIT)
        act = g * jax.nn.sigmoid(SWIGLU_ALPHA * g) * (u + 1)
        return act @ w_down[e] + b_down[e]

    yb = lax.map(expert_block, (xb, block_expert)).reshape(cap, D)
    y = jax.ops.segment_sum(yb * buf_gate[:, None].astype(yb.dtype), buf_tok, num_segments=T + 1)
    return y[:T]


def setup_inputs(seed: int = 0) -> dict:
    key = jax.random.key(seed)
    ks = iter(jax.random.split(key, 32))
    f32 = jnp.float32

    def nrm(shape, scale):
        return jax.random.normal(next(ks), shape, f32) * scale

    def gain(shape):
        return jnp.ones(shape, f32) + nrm(shape, 0.05)

    D = D_MODEL
    qkv_w = (N_Q_HEADS + 2 * N_KV_HEADS) * HEAD_DIM
    return {
        'x': nrm((BATCH, SEQ, D), 1.0),
        'c': nrm((BATCH, D), 1.0),
        'ctx': nrm((BATCH, CTX_LEN, D), 1.0),
        'c_ctx': nrm((D,), 1.0),
        'ada_w': nrm((DEPTH, D, N_MOD * D), 0.5 * D ** -0.5),
        'ada_b': nrm((DEPTH, N_MOD * D), 0.02),
        'norm_mix': gain((DEPTH, D)),
        'norm_ffn': gain((DEPTH, D)),
        'gm_w_in': nrm((N_A_LAYERS, D, 2 * GM_WIDTH), D ** -0.5),
        'gm_b_in': nrm((N_A_LAYERS, 2 * GM_WIDTH), 0.02),
        'gm_v_gain': gain((N_A_LAYERS, GM_WIDTH)),
        'gm_w_s': nrm((N_A_LAYERS, GM_GROUPS, CHUNK, CHUNK), CHUNK ** -0.5),
        'gm_b_s': gain((N_A_LAYERS, GM_GROUPS, CHUNK)),
        'gm_w_out': nrm((N_A_LAYERS, GM_WIDTH, D), GM_WIDTH ** -0.5),
        'at_w_qkv': nrm((N_B_LAYERS, D, qkv_w), D ** -0.5),
        'at_q_gain': gain((N_B_LAYERS, HEAD_DIM)),
        'at_k_gain': gain((N_B_LAYERS, HEAD_DIM)),
        'at_w_o': nrm((N_B_LAYERS, N_Q_HEADS * HEAD_DIM, D), (N_Q_HEADS * HEAD_DIM) ** -0.5),
        'moe_router_w': nrm((DEPTH, D, N_EXPERTS), D ** -0.5),
        'moe_router_b': nrm((DEPTH, N_EXPERTS), 0.01),
        'moe_w_gu': nrm((DEPTH, N_EXPERTS, D, 2 * D_EXPERT), D ** -0.5),
        'moe_b_gu': nrm((DEPTH, N_EXPERTS, 2 * D_EXPERT), 0.02),
        'moe_w_down': nrm((DEPTH, N_EXPERTS, D_EXPERT, D), D_EXPERT ** -0.5),
        'moe_b_down': nrm((DEPTH, N_EXPERTS, D), 0.02),
    }


def reference(x, c, ctx, c_ctx, ada_w, ada_b, norm_mix, norm_ffn,
              gm_w_in, gm_b_in, gm_v_gain, gm_w_s, gm_b_s, gm_w_out,
              at_w_qkv, at_q_gain, at_k_gain, at_w_o,
              moe_router_w, moe_router_b, moe_w_gu, moe_b_gu, moe_w_down, moe_b_down):
    B_, n_lat, D = x.shape
    n_ctx = ctx.shape[1]
    rows = n_lat // GRID_W
    cos, sin = axial_rope_tables(rows)
    silu_c = jax.nn.silu(c)
    silu_cc = jax.nn.silu(c_ctx)
    x_lat, x_ctx = x, ctx
    for i in range(DEPTH):
        last = i == DEPTH - 1
        mod_l = jnp.split(silu_c @ ada_w[i] + ada_b[i], N_MOD, axis=-1)
        mod_l = [m[:, None, :] for m in mod_l]
        mod_c = jnp.split(silu_cc @ ada_w[i] + ada_b[i], N_MOD, axis=-1)
        sh1, sc1, g1, sh2, sc2, g2 = mod_l
        csh1, csc1, cg1, csh2, csc2, cg2 = mod_c
        h_l = modulate(rmsnorm(x_lat, norm_mix[i]), sh1, sc1)
        h_c = modulate(rmsnorm(x_ctx, norm_mix[i]), csh1, csc1)
        if i % N_MIXERS == 0:
            a = i // N_MIXERS
            y_l = chunk_gmlp(h_l, gm_w_in[a], gm_b_in[a], gm_v_gain[a], gm_w_s[a], gm_b_s[a], gm_w_out[a])
            y_c = None if last else chunk_gmlp(h_c, gm_w_in[a], gm_b_in[a], gm_v_gain[a],
                                               gm_w_s[a], gm_b_s[a], gm_w_out[a])
        else:
            b = i // N_MIXERS
            y_l, y_c = gqa_mixer(h_l, h_c, at_w_qkv[b], at_q_gain[b], at_k_gain[b], at_w_o[b],
                                 cos, sin, not last)
        x_lat = x_lat + g1 * y_l
        if not last:
            x_ctx = x_ctx + cg1 * y_c
        f_l = modulate(rmsnorm(x_lat, norm_ffn[i]), sh2, sc2).reshape(B_ * n_lat, D)
        if last:
            tokens = f_l
        else:
            f_c = modulate(rmsnorm(x_ctx, norm_ffn[i]), csh2, csc2).reshape(B_ * n_ctx, D)
            tokens = jnp.concatenate([f_c, f_l], axis=0)
        y = moe_ffn(tokens, moe_router_w[i], moe_router_b[i], moe_w_gu[i], moe_b_gu[i],
                    moe_w_down[i], moe_b_down[i])
        if last:
            x_lat = x_lat + g2 * y.reshape(B_, n_lat, D)
        else:
            x_ctx = x_ctx + cg2 * y[:B_ * n_ctx].reshape(B_, n_ctx, D)
            x_lat = x_lat + g2 * y[B_ * n_ctx:].reshape(B_, n_lat, D)
    return x_lat
```

```cpp
#include <hip/hip_runtime.h>
#include <cstdio>
#include <cstdint>

#ifndef MK_REPEAT_MASK
#define MK_REPEAT_MASK 0u
#endif
#ifndef MK_N_LAUNCHES
#define MK_N_LAUNCHES 1
#endif

#define LAS __attribute__((address_space(3)))
typedef unsigned short bf16_t;
typedef short bf16x8 __attribute__((ext_vector_type(8)));
typedef short s16x4 __attribute__((ext_vector_type(4)));
typedef float f32x2 __attribute__((ext_vector_type(2)));
typedef float f32x4 __attribute__((ext_vector_type(4)));
typedef float f32x16 __attribute__((ext_vector_type(16)));
typedef unsigned u32x2 __attribute__((ext_vector_type(2)));
typedef unsigned u32x4 __attribute__((ext_vector_type(4)));
typedef int i32x4 __attribute__((ext_vector_type(4)));
typedef int i32x8 __attribute__((ext_vector_type(8)));

constexpr int NB = 8, LSEQ = 2048, CTXL = 256, DM = 1024, TBR = LSEQ + CTXL, T = NB * TBR, TL = NB * LSEQ;
constexpr int NE = 32, TOPK = 4, ECAP = T;
constexpr int SLOTS_MAX = T * TOPK + NE * 256;
constexpr int GMW = 2048, QKVW = 1536, HD = 128;
constexpr float NORM_EPS = 1e-6f;
constexpr int NTHREADS = 512;

constexpr size_t al256(size_t x) { return (x + 255) & ~(size_t)255; }
constexpr size_t WS_BAR   = 0;
constexpr size_t WS_CNT   = 16384;
constexpr size_t WS_QHEAD = 32768;
constexpr size_t WS_PHDONE = 32768 + 1024;
constexpr size_t WS_ZERO_BYTES = 65536;
constexpr size_t WS_MOD   = WS_ZERO_BYTES;
constexpr size_t WS_RWH   = WS_MOD + al256((size_t)2 * 9 * 6144 * 4);
constexpr size_t WS_RWL   = WS_RWH + (size_t)2 * 32 * 1024 * 2;
constexpr size_t WS_WIN   = WS_RWL + (size_t)2 * 32 * 1024 * 2;
constexpr size_t WS_WOUT  = WS_WIN + (size_t)4096 * 1024 * 2;
constexpr size_t WS_WQKV  = WS_WOUT + (size_t)1024 * 2048 * 2;
constexpr size_t WS_WO    = WS_WQKV + (size_t)1536 * 1024 * 2;
constexpr size_t WS_WGU   = WS_WO + (size_t)1024 * 1024 * 2;
constexpr size_t WS_WDN   = WS_WGU + (size_t)64 * 2048 * 1024 * 2;
constexpr size_t WS_HBUF  = WS_WDN + (size_t)64 * 1024 * 1024 * 2;
constexpr size_t WS_UV    = WS_HBUF + (size_t)T * 1024 * 2;
constexpr size_t WS_VSS   = WS_UV + (size_t)T * 4096 * 2;
constexpr size_t WS_TBUF  = WS_VSS + (size_t)T * 32 * 4;
constexpr size_t WS_X1    = WS_TBUF + (size_t)T * 2048 * 2;
constexpr size_t WS_FBUF  = WS_X1 + (size_t)T * 1024 * 4;
constexpr size_t WS_TE    = WS_FBUF + (size_t)T * 1024 * 2;
constexpr size_t WS_TP    = WS_TE + (size_t)2 * T * 4 * 4;
constexpr size_t WS_TG    = WS_TP + (size_t)2 * T * 4 * 4;
constexpr size_t WS_LIST  = WS_TG + (size_t)2 * T * 4 * 4;
constexpr size_t WS_XG    = WS_LIST + (size_t)2 * NE * ECAP * 4;
constexpr size_t WS_ACT   = WS_XG + (size_t)SLOTS_MAX * 1024 * 2;
constexpr size_t WS_YB    = WS_ACT + (size_t)SLOTS_MAX * 1024 * 2;
constexpr size_t WS_X2C   = WS_YB + (size_t)SLOTS_MAX * 1024 * 2;
constexpr size_t WS_QKV   = WS_X2C + (size_t)TL * 1024 * 4;
constexpr size_t WS_QB    = WS_QKV + (size_t)T * 1536 * 2;
constexpr size_t WS_KB    = WS_QB + (size_t)TL * 1024 * 2;
constexpr size_t WS_VB    = WS_KB + (size_t)T * 256 * 2;
constexpr size_t WS_OB    = WS_VB + (size_t)T * 256 * 2;
constexpr size_t WS_X3C   = WS_OB + (size_t)TL * 1024 * 2;
constexpr size_t WS_END   = WS_X3C + (size_t)TL * 1024 * 4;

constexpr int RING_BYTES = 131072, MISC_OFF = RING_BYTES, RL_OFF = MISC_OFF + 512, QKP_OFF = RL_OFF + 2048, LDS_BYTES = RING_BYTES + 512 + 2048 + 8192;

struct Params {
    const float *x, *c, *ctx, *c_ctx, *ada_w, *ada_b, *norm_mix, *norm_ffn, *gm_w_in, *gm_b_in, *gm_v_gain, *gm_w_s, *gm_b_s, *gm_w_out,
                *at_w_qkv, *at_q_gain, *at_k_gain, *at_w_o, *router_w, *router_b, *w_gu, *b_gu, *w_dn, *b_dn;
    float* out; unsigned char* ws; int ph_lo, ph_hi;
};

__device__ __forceinline__ unsigned cvt_pk_bf16(float lo, float hi) { unsigned r; asm volatile("v_cvt_pk_bf16_f32 %0, %1, %2" : "=v"(r) : "v"(lo), "v"(hi)); return r; }
__device__ __forceinline__ unsigned pk_fp8x4(float a, float b, float c, float d) {
    a = __builtin_amdgcn_fmed3f(a, -448.f, 448.f); b = __builtin_amdgcn_fmed3f(b, -448.f, 448.f); c = __builtin_amdgcn_fmed3f(c, -448.f, 448.f); d = __builtin_amdgcn_fmed3f(d, -448.f, 448.f);
    int w = __builtin_amdgcn_cvt_pk_fp8_f32(a, b, 0, false); w = __builtin_amdgcn_cvt_pk_fp8_f32(c, d, w, true); return (unsigned)w;
}
__device__ __forceinline__ unsigned pk_fp8x4_nc(float a, float b, float c, float d) {
    int w = __builtin_amdgcn_cvt_pk_fp8_f32(a, b, 0, false); w = __builtin_amdgcn_cvt_pk_fp8_f32(c, d, w, true); return (unsigned)w;
}
constexpr float F8_SX = 32.f, F8_SW = 256.f, F8_SA = 4.f, F8_SY = 64.f;
constexpr int F8_EX = 0x7a7a7a7a, F8_EW = 0x77777777, F8_EA = 0x7d7d7d7d;
__device__ __forceinline__ float bf_lo(unsigned w) { return __uint_as_float(w << 16); }
__device__ __forceinline__ float bf_hi(unsigned w) { return __uint_as_float(w & 0xffff0000u); }
__device__ __forceinline__ float wave_sum(float v) {
#pragma unroll
    for (int o = 32; o >= 1; o >>= 1) v += __shfl_xor(v, o);
    return v;
}
__device__ __forceinline__ int ld_agent(const int* p) { return __hip_atomic_load(p, __ATOMIC_RELAXED, __HIP_MEMORY_SCOPE_AGENT); }
__device__ __forceinline__ int mod_row(int r) { const int b = r / TBR, p = r - b * TBR; return p < CTXL ? 8 : b; }
__device__ __forceinline__ const float* src_row(const Params& P, int r) {
    const int b = r / TBR, p = r - b * TBR;
    return p < CTXL ? P.ctx + (size_t)(b * CTXL + p) * DM : P.x + (size_t)(b * LSEQ + p - CTXL) * DM;
}

#define XB_TMO      128
#define XB_XCNT(j)  (256  + 64 * (j))
#define XB_XSUB(j)  (1280 + 64 * (j))
#define XB_XGEN(j)  (2304 + 64 * (j))
#define XB_TOP      3328
#define XB_TOPGEN   3392
#define XCD_BAR_WORDS 3456
#define XB_SPIN_CAP (1u << 18)
__device__ __forceinline__ unsigned xb_ld(unsigned* p)              { return __hip_atomic_load(p, __ATOMIC_RELAXED, __HIP_MEMORY_SCOPE_AGENT); }
__device__ __forceinline__ unsigned xb_add(unsigned* p, unsigned v) { return __hip_atomic_fetch_add(p, v, __ATOMIC_RELAXED, __HIP_MEMORY_SCOPE_AGENT); }
__device__ __forceinline__ unsigned xb_xcc_id() { return (unsigned)__builtin_amdgcn_s_getreg((3 << 11) | 20) & 0xFu; }
#define XB_SPIN(cond, bar) do { unsigned _sp = 0; while (cond) { __builtin_amdgcn_s_sleep(1); \
    if ((++_sp & 255u) == 0u) { if (xb_ld(&(bar)[XB_TMO])) break; if (_sp > XB_SPIN_CAP) { atomicAdd(&(bar)[XB_TMO], 1u); break; } } } } while (0)
struct XcdBarrier { unsigned* bar; unsigned x; volatile LAS unsigned* st; };
__device__ __forceinline__ XcdBarrier xcd_barrier_post(unsigned* bar, volatile LAS unsigned* st) {
    XcdBarrier b; b.bar = bar; b.x = xb_xcc_id(); b.st = st;
    if (threadIdx.x == 0) (void)xb_add(&bar[XB_XCNT(b.x)], 1u);
    return b;
}
__device__ __forceinline__ void xcd_barrier_complete(unsigned* bar, unsigned x, unsigned& nloc, unsigned& nx) {
    const unsigned G = gridDim.x * gridDim.y * gridDim.z;
    unsigned sum, cnt, mine, sp = 0u;
    for (;;) {
        sum = 0u; cnt = 0u; mine = 0u;
#pragma unroll
        for (unsigned j = 0; j < 16; ++j) { const unsigned c = xb_ld(&bar[XB_XCNT(j)]); sum += c; cnt += (c > 0u) ? 1u : 0u; mine = (j == x) ? c : mine; }
        if (sum == G) break;
        __builtin_amdgcn_s_sleep(1);
        if ((++sp & 255u) == 0u) { if (xb_ld(&bar[XB_TMO])) break; if (sp > XB_SPIN_CAP) { atomicAdd(&bar[XB_TMO], 1u); break; } }
    }
    nloc = mine > 0u ? mine : 1u; nx = cnt > 0u ? cnt : 1u;
}
__device__ __forceinline__ void xcd_barrier(const XcdBarrier& b) {
    asm volatile("s_waitcnt vmcnt(0)" ::: "memory");
    __syncthreads();
    if (threadIdx.x == 0) {
        unsigned* bar = b.bar;
        __builtin_amdgcn_s_waitcnt(0);
        unsigned nloc = b.st[0], nx = b.st[1];
        if (nloc == 0u) { xcd_barrier_complete(bar, b.x, nloc, nx); b.st[0] = nloc; b.st[1] = nx; }
        const unsigned old = xb_add(&bar[XB_XSUB(b.x)], 1u);
        const unsigned gen = old / nloc;
        if (old + 1u == (gen + 1u) * nloc) {
            __builtin_amdgcn_fence(__ATOMIC_RELEASE, "agent");
            asm volatile("s_waitcnt vmcnt(0)" ::: "memory");
            const unsigned og = xb_add(&bar[XB_TOP], 1u);
            const unsigned tg = og / nx;
            if (og + 1u == (tg + 1u) * nx) xb_add(&bar[XB_TOPGEN], 1u);
            else XB_SPIN(xb_ld(&bar[XB_TOPGEN]) == tg, bar);
            __builtin_amdgcn_fence(__ATOMIC_ACQUIRE, "agent");
            xb_add(&bar[XB_XGEN(b.x)], 1u);
            asm volatile("s_waitcnt vmcnt(0)" ::: "memory");
        } else {
            XB_SPIN(xb_ld(&bar[XB_XGEN(b.x)]) == gen, bar);
            __builtin_amdgcn_fence(__ATOMIC_ACQUIRE, "agent");
            asm volatile("s_waitcnt vmcnt(0)" ::: "memory");
        }
    }
    __syncthreads();
}

namespace pg8 {
constexpr int BM = 256, BK = 64, HALF = 128, HTB = HALF * BK * 2, STAGE_BYTES = 8 * HTB, NXCD = 8, WGM = 8;
__device__ __forceinline__ int lds_byte(int r, int c) { const int st = (r >> 4) * 2 + (c >> 5), rr = r & 15, cc = c & 31, ob = rr * 64 + cc * 2; return st * 1024 + (ob ^ (((ob >> 9) & 1) << 5)); }
__device__ __forceinline__ void stage_rc(int b, int& R, int& C) { const int st = b / 1024, sb = b % 1024, swz = sb ^ (((sb >> 9) & 1) << 5); R = (st >> 1) * 16 + swz / 64; C = (st & 1) * 32 + (swz % 64) / 2; }
__device__ __forceinline__ int perm32(int rho) { const int n = rho >> 4, i = rho & 15; return 8 * (i >> 2) + 4 * n + (i & 3); }

struct Unit { const char* A; const char* B; const int* rl; int pm, pn, aux, nvalid; };

__device__ __forceinline__ bool static_unit(int i, int G, int c, int nM, int nN, int& pm, int& pn) {
    const int nwg = nM * nN; const long L = (long)i * G + c; if (L >= nwg) return false;
    int wgid = (int)L; { const int q = nwg / NXCD, r = nwg % NXCD, xcd = wgid % NXCD, off = wgid / NXCD; wgid = (xcd < r ? xcd * (q + 1) : r * (q + 1) + (xcd - r) * q) + off; }
    const int nig = WGM * nN, gid = wgid / nig, fm = gid * WGM, gsz = (nM - fm) < WGM ? (nM - fm) : WGM;
    pm = fm + ((wgid % nig) % gsz); pn = (wgid % nig) / gsz; return true;
}
struct StaticOrder {
    const char* A; const char* Bt; int nM, nN, G, c; size_t tstepA, tstepB;
    __device__ __forceinline__ void init(const void* A_, const void* Bt_, int M, int N, int K, int G_, int c_) { A = (const char*)A_; Bt = (const char*)Bt_; nM = M / BM; nN = N / BM; G = G_; c = c_; tstepA = (size_t)BM * K * 2; tstepB = tstepA; }
    __device__ __forceinline__ bool next(int i, Unit& u) const {
        int pm, pn; if (!static_unit(i, G, c, nM, nN, pm, pn)) return false;
        u.pm = pm; u.pn = pn; u.aux = 0; u.rl = nullptr; u.nvalid = 256; u.A = A + (size_t)pm * tstepA; u.B = Bt + (size_t)pn * tstepB; return true;
    }
};

__device__ __forceinline__ void glds16(unsigned voff, const void* sbase, unsigned lds_addr) {
    unsigned keep;
    asm volatile("s_mov_b32 %0, m0\n\ts_mov_b32 m0, %3\n\ts_nop 0\n\tglobal_load_lds_dwordx4 %1, %2\n\ts_mov_b32 m0, %0" : "=&s"(keep) : "v"(voff), "s"(sbase), "s"(lds_addr) : "memory");
}
__device__ __forceinline__ void glds4(unsigned voff, const void* sbase, unsigned lds_addr) {
    unsigned keep;
    asm volatile("s_mov_b32 %0, m0\n\ts_mov_b32 m0, %3\n\ts_nop 0\n\tglobal_load_lds_dword %1, %2\n\ts_mov_b32 m0, %0" : "=&s"(keep) : "v"(voff), "s"(sbase), "s"(lds_addr) : "memory");
}
template <bool FP8, int SCW, int SCX, bool GATHER, class Epi, class Sched>
__device__ __forceinline__ void gemm_phase(LAS unsigned char* lds, LAS int* rlbuf, const int K, const size_t hstepB, const Sched& S, const Epi& E) {
    const int tid = threadIdx.x, wid = __builtin_amdgcn_readfirstlane(tid >> 6), lane = tid & 63, wr = wid >> 2, wc = wid & 3, fr = lane & 15, fq = lane >> 4;
    const int nt = K / BK;
    u32x2 vb0, vb1; unsigned vc[2][2], vn[2][2]; int gR[2], gC[2];
#pragma unroll
    for (int i = 0; i < 2; ++i) { int R, C; stage_rc(tid * 16 + i * 8192, R, C);
        gR[i] = R; gC[i] = C * 2; vb0[i] = (unsigned)(Epi::browh(R, 0) * K + C) * 2u; vb1[i] = (unsigned)(Epi::browh(R, 1) * K + C) * 2u;
#pragma unroll
        for (int h = 0; h < 2; ++h) { vc[h][i] = (unsigned)((R + h * HALF) * K + C) * 2u; vn[h][i] = vc[h][i]; } }
    const size_t kstep = (size_t)(BK * 2);
    const unsigned ldsw = (unsigned)wid * 1024u;
    const int aoff = lds_byte(wr * 64 + fr, fq * 8), boff = lds_byte(wc * 32 + fr, fq * 8);
    LAS unsigned char* ldsA = lds + aoff; LAS unsigned char* ldsB = lds + 4 * HTB + boff;
    asm volatile("" : "+v"(ldsA), "+v"(ldsB));
#define PG8_SA(b, h) (((b) * 2 + (h)) * HTB)
#define PG8_SB(b, h) ((4 + (b) * 2 + (h)) * HTB)
#define PG8_STAGE(bufoff, gbase, voff) do { _Pragma("unroll") for (int _i = 0; _i < 2; ++_i) \
        glds16((voff)[_i], (const void*)(gbase), (unsigned)(uintptr_t)(lds + (bufoff) + ldsw + _i * 8192)); } while (0)
#define PG8_STAGEA(bufoff, gbase, vo) do { _Pragma("unroll") for (int _i = 0; _i < 2; ++_i) \
        glds16((vo)[_i], (const void*)(gbase), (unsigned)(uintptr_t)(lds + (bufoff) + ldsw + _i * 8192)); } while (0)
#define PG8_RLREAD(dst, buf, nv) do { _Pragma("unroll") for (int _h = 0; _h < 2; ++_h) _Pragma("unroll") for (int _i = 0; _i < 2; ++_i) { const int _r = gR[_i] + _h * HALF; \
        const int _t = (_r < (nv)) ? rlbuf[(buf) * 256 + _r] : 0; dst[_h][_i] = (unsigned)_t * (unsigned)(K * 2) + (unsigned)gC[_i]; } } while (0)
#define PG8_LD8(base, off) __builtin_shufflevector(*(const LAS i32x4*)((base) + (off)), *(const LAS i32x4*)((base) + (off) + 1024), 0, 1, 2, 3, 4, 5, 6, 7)
#define PG8_LDA(dst, b, h) do { _Pragma("unroll") for (int m = 0; m < 4; ++m) dst[m] = PG8_LD8(ldsA, ((b) * 2 + (h)) * HTB + m * 2048); } while (0)
#define PG8_LDB(dst, b, h) do { _Pragma("unroll") for (int n = 0; n < 2; ++n) dst[n] = PG8_LD8(ldsB, ((b) * 2 + (h)) * HTB + n * 2048); } while (0)
#define PG8_H0(x) ((bf16x8)__builtin_shufflevector(x, x, 0, 1, 2, 3))
#define PG8_H1(x) ((bf16x8)__builtin_shufflevector(x, x, 4, 5, 6, 7))
#define PG8_MMA(ai, bj, At, Bt) do { __builtin_amdgcn_s_setprio(1); _Pragma("unroll") for (int m = 0; m < 4; ++m) _Pragma("unroll") for (int n = 0; n < 2; ++n) { \
        if constexpr (FP8) asm volatile("v_mfma_scale_f32_16x16x128_f8f6f4 %0, %1, %2, %0, %3, %4 op_sel_hi:[0,0,0]" : "+v"(acc[ai][bj][m][n]) : "v"(Bt[n]), "v"(At[m]), "v"(scw), "v"(scx)); \
        else { acc[ai][bj][m][n] = __builtin_amdgcn_mfma_f32_16x16x32_bf16(PG8_H0(Bt[n]), PG8_H0(At[m]), acc[ai][bj][m][n], 0, 0, 0); \
               acc[ai][bj][m][n] = __builtin_amdgcn_mfma_f32_16x16x32_bf16(PG8_H1(Bt[n]), PG8_H1(At[m]), acc[ai][bj][m][n], 0, 0, 0); } } \
        __builtin_amdgcn_s_setprio(0); } while (0)
#define PG8_WAIT_V(n) asm volatile("s_waitcnt vmcnt(" #n ")" ::: "memory")
#define PG8_WAIT_L(n) asm volatile("s_waitcnt lgkmcnt(" #n ")" ::: "memory")
#define PG8_BAR __builtin_amdgcn_s_barrier()
#define PG8_SCHED __builtin_amdgcn_sched_barrier(0)
    Unit cur, nxt; int ui = 0;
    if (!S.next(0, cur)) return;
    int scw = SCW, scx = SCX;
    if constexpr (FP8) asm volatile("" : "+v"(scw), "+v"(scx));
    f32x4 acc[2][2][4][2];
#pragma unroll
    for (int a = 0; a < 2; ++a)
#pragma unroll
        for (int b = 0; b < 2; ++b)
#pragma unroll
            for (int m = 0; m < 4; ++m)
#pragma unroll
                for (int n = 0; n < 2; ++n) acc[a][b][m][n] = (f32x4){0.f, 0.f, 0.f, 0.f};
    i32x8 At[4], B0[2], B1[2];
    const char* cA = cur.A; const char* cB = cur.B;
    if constexpr (GATHER) {
        if (tid < 256) rlbuf[tid] = cur.rl[tid];
        __syncthreads();
        PG8_RLREAD(vc, 0, cur.nvalid);
    }
    PG8_STAGE(PG8_SB(0, 0), cB, vb0); PG8_STAGE(PG8_SB(0, 1), cB + hstepB, vb1); PG8_STAGEA(PG8_SA(0, 0), cA, vc[0]); PG8_STAGEA(PG8_SA(0, 1), cA, vc[1]);
    if (wr == 1) PG8_BAR;
    PG8_WAIT_V(2); PG8_BAR;
    PG8_STAGE(PG8_SB(1, 0), cB + kstep, vb0); PG8_STAGEA(PG8_SA(1, 0), cA + kstep, vc[0]); PG8_STAGE(PG8_SB(1, 1), cB + hstepB + kstep, vb1);
    PG8_WAIT_V(6); PG8_BAR;
    for (;;) {
        const bool has_next = S.next(ui + 1, nxt);
        const char* nA = has_next ? nxt.A : cA; const char* nB = has_next ? nxt.B : cB;
        if constexpr (GATHER) { if (has_next && tid < 256) glds4((unsigned)lane * 4u, (const void*)(nxt.rl + wid * 64), (unsigned)(uintptr_t)(rlbuf + ((ui + 1) & 1) * 256 + wid * 64)); }
#pragma unroll 1
        for (int t = 0; t < nt; t += 2) {
            const bool last = (t == nt - 2);
            const char* a1 = cA + (size_t)(t + 1) * kstep;
            const char* a2 = last ? nA : cA + (size_t)(t + 2) * kstep; const char* b2 = last ? nB : cB + (size_t)(t + 2) * kstep;
            const char* a3 = a2 + kstep; const char* b3 = b2 + kstep;
            if constexpr (GATHER) { if (last && has_next) PG8_RLREAD(vn, (ui + 1) & 1, nxt.nvalid); }
            unsigned v0[2], v1[2];
#pragma unroll
            for (int i = 0; i < 2; ++i) { v0[i] = (GATHER && last) ? vn[0][i] : vc[0][i]; v1[i] = (GATHER && last) ? vn[1][i] : vc[1][i]; }
            const bool lenient = (t == 0) && (ui > 0);
            PG8_LDB(B0, 0, 0); PG8_LDB(B1, 0, 1); PG8_SCHED; PG8_LDA(At, 0, 0); PG8_STAGEA(PG8_SA(1, 1), a1, vc[1]);
            if (!lenient) PG8_WAIT_V(8);
            PG8_WAIT_L(0); PG8_BAR; PG8_MMA(0, 0, At, B0); PG8_MMA(0, 1, At, B1); PG8_BAR; PG8_SCHED;
            PG8_LDA(At, 0, 1); PG8_STAGE(PG8_SB(0, 0), b2, vb0); PG8_STAGE(PG8_SB(0, 1), b2 + hstepB, vb1); PG8_STAGEA(PG8_SA(0, 0), a2, v0);
            if (!lenient) PG8_WAIT_V(8);
            PG8_WAIT_L(0); PG8_BAR; PG8_MMA(1, 0, At, B0); PG8_MMA(1, 1, At, B1); PG8_BAR; PG8_SCHED;
            PG8_LDB(B0, 1, 0); PG8_LDB(B1, 1, 1); PG8_SCHED; PG8_LDA(At, 1, 0); PG8_STAGEA(PG8_SA(0, 1), a2, v1);
            PG8_WAIT_V(8); PG8_WAIT_L(0); PG8_BAR; PG8_MMA(0, 0, At, B0); PG8_MMA(0, 1, At, B1); PG8_BAR; PG8_SCHED;
            PG8_LDA(At, 1, 1); PG8_STAGE(PG8_SB(1, 0), b3, vb0); PG8_STAGE(PG8_SB(1, 1), b3 + hstepB, vb1); PG8_STAGEA(PG8_SA(1, 0), a3, v0);
            PG8_WAIT_V(8); PG8_WAIT_L(0); PG8_BAR; PG8_MMA(1, 0, At, B0); PG8_MMA(1, 1, At, B1); PG8_BAR; PG8_SCHED;
        }
        if (wr == 0) PG8_BAR;
        if constexpr (FP8) asm volatile("s_nop 15\n\ts_nop 15" ::: "memory");
        if constexpr (Epi::NEEDS_DRAIN) PG8_WAIT_V(0);
        { int fr_ = fr, fq_ = fq; asm volatile("" : "+v"(fr_), "+v"(fq_));
          E(acc, cur, wr, wc, fr_, fq_); }
        if (!has_next) break;
#pragma unroll
        for (int a = 0; a < 2; ++a)
#pragma unroll
            for (int b = 0; b < 2; ++b)
#pragma unroll
                for (int m = 0; m < 4; ++m)
#pragma unroll
                    for (int n = 0; n < 2; ++n) acc[a][b][m][n] = (f32x4){0.f, 0.f, 0.f, 0.f};
        cur = nxt; cA = nA; cB = nB; ++ui;
        if constexpr (GATHER) {
#pragma unroll
            for (int h = 0; h < 2; ++h)
#pragma unroll
                for (int i = 0; i < 2; ++i) vc[h][i] = vn[h][i]; }
        if (wr == 1) PG8_BAR;
    }
    PG8_WAIT_V(0);
    PG8_BAR;
#undef PG8_SA
#undef PG8_SB
#undef PG8_STAGE
#undef PG8_STAGEA
#undef PG8_RLREAD
#undef PG8_LDA
#undef PG8_LDB
#undef PG8_LD8
#undef PG8_H0
#undef PG8_H1
#undef PG8_MMA
#undef PG8_WAIT_V
#undef PG8_WAIT_L
#undef PG8_BAR
#undef PG8_SCHED
}

__device__ __forceinline__ f32x2 gelu_pk(f32x2 v) {
    const f32x2 av = __builtin_elementwise_abs(v), d = av * 0.2316418882f + 1.0f;
    f32x2 t; t.x = __builtin_amdgcn_rcpf(d.x); t.y = __builtin_amdgcn_rcpf(d.y);
    f32x2 q = t * 0.5307027145f + (-0.7265760135f); q = q * t + 0.7107068705f; q = q * t + (-0.142248368f); q = q * t + 0.127414796f; q = q * t;
    const f32x2 s = (v * v) * (-0.72134752044f);
    f32x2 e; e.x = __builtin_amdgcn_exp2f(s.x); e.y = __builtin_amdgcn_exp2f(s.y);
    const f32x2 m = v * (q * e), r = v - m;
    f32x2 o; o.x = v.x < 0.f ? m.x : r.x; o.y = v.y < 0.f ? m.y : r.y; return o;
}
struct EpiFp8 {
    static constexpr bool PERM = true, NEEDS_DRAIN = false;
    static __device__ __forceinline__ int browh(int R, int h) { return 16 * (4 * (R >> 5) + ((R & 15) >> 2)) + 8 * h + 4 * ((R >> 4) & 1) + (R & 3); }
    unsigned char* O; const float* bias;
    __device__ __forceinline__ void operator()(const f32x4 (&acc)[2][2][4][2], const Unit& u, int wr, int wc, int fr, int fq) const {
        const int row0 = u.pm * BM + wr * 64 + fr, col0 = u.pn * BM + 16 * (4 * wc + fq);
        const float* bb = bias + (size_t)u.aux * 1024 + col0;
        f32x4 bv[2][2];
#pragma unroll
        for (int bj = 0; bj < 2; ++bj)
#pragma unroll
            for (int n = 0; n < 2; ++n) bv[bj][n] = *(const f32x4*)(bb + 8 * bj + 4 * n);
#pragma unroll
        for (int ai = 0; ai < 2; ++ai)
#pragma unroll
            for (int m = 0; m < 4; ++m) { u32x4 w;
#pragma unroll
                for (int bj = 0; bj < 2; ++bj) { const f32x4 v0 = (acc[ai][bj][m][0] + bv[bj][0]) * F8_SY, v1 = (acc[ai][bj][m][1] + bv[bj][1]) * F8_SY;
                    w[2 * bj] = pk_fp8x4(v0[0], v0[1], v0[2], v0[3]); w[2 * bj + 1] = pk_fp8x4(v1[0], v1[1], v1[2], v1[3]); }
                *(u32x4*)(O + (size_t)(row0 + ai * HALF + m * 16) * 1024 + col0) = w; }
    }
};
struct EpiGeluV {
    static constexpr bool PERM = true, NEEDS_DRAIN = false; static __device__ __forceinline__ int browh(int R, int) { return (R & ~31) + perm32(R & 31); }
    bf16_t* O; const float* bias; float* vss;
    __device__ __forceinline__ void operator()(const f32x4 (&acc)[2][2][4][2], const Unit& u, int wr, int wc, int fr, int fq) const {
        const int row0 = u.pm * BM + wr * 64 + fr, col0 = u.pn * BM + wc * 32 + 8 * fq;
        f32x4 bv[2][2];
#pragma unroll
        for (int bj = 0; bj < 2; ++bj)
#pragma unroll
            for (int n = 0; n < 2; ++n) bv[bj][n] = *(const f32x4*)(bias + col0 + bj * HALF + 4 * n);
#pragma unroll
        for (int ai = 0; ai < 2; ++ai)
#pragma unroll
            for (int m = 0; m < 4; ++m) { const int row = row0 + ai * HALF + m * 16; bf16_t* rowp = O + (size_t)row * 4096 + col0; float ssq = 0.f;
                if (u.pn < 8) {
#pragma unroll
                    for (int bj = 0; bj < 2; ++bj) { const f32x4 v0 = acc[ai][bj][m][0] + bv[bj][0], v1 = acc[ai][bj][m][1] + bv[bj][1];
                        u32x4 w; w.x = cvt_pk_bf16(v0[0], v0[1]); w.y = cvt_pk_bf16(v0[2], v0[3]); w.z = cvt_pk_bf16(v1[0], v1[1]); w.w = cvt_pk_bf16(v1[2], v1[3]);
                        *(u32x4*)(rowp + bj * HALF) = w; }
                    continue; }
#pragma unroll
                for (int bj = 0; bj < 2; ++bj) { f32x4 v0 = acc[ai][bj][m][0] + bv[bj][0], v1 = acc[ai][bj][m][1] + bv[bj][1];
                    const f32x2 a = gelu_pk((f32x2){v0[0], v0[1]}), b = gelu_pk((f32x2){v0[2], v0[3]}), c = gelu_pk((f32x2){v1[0], v1[1]}), d = gelu_pk((f32x2){v1[2], v1[3]});
                    ssq += (a.x * a.x + a.y * a.y) + (b.x * b.x + b.y * b.y) + (c.x * c.x + c.y * c.y) + (d.x * d.x + d.y * d.y);
                    u32x4 w; w.x = cvt_pk_bf16(a.x, a.y); w.y = cvt_pk_bf16(b.x, b.y); w.z = cvt_pk_bf16(c.x, c.y); w.w = cvt_pk_bf16(d.x, d.y);
                    *(u32x4*)(rowp + bj * HALF) = w; }
                ssq += __shfl_xor(ssq, 16); ssq += __shfl_xor(ssq, 32); if (fq == 0) vss[(size_t)row * 32 + (u.pn - 8) * 4 + wc] = ssq; }
    }
};
struct EpiQKV {
    static constexpr bool PERM = true, NEEDS_DRAIN = false;
    static __device__ __forceinline__ int browh(int R, int) { return (R & ~0x30) | ((R & 0x10) << 1) | ((R & 0x20) >> 1); }
    bf16_t* Qb; bf16_t* Kb; bf16_t* Vb; const float* qgain; const float* kgain; LAS float* P;
    __device__ __forceinline__ void operator()(const f32x4 (&acc)[2][2][4][2], const Unit& u, int wr, int wc, int fr, int fq) const {
        const int b = u.pm / 9, jt = u.pm - 9 * b; const bool lat = jt != 0;
        const int d0 = 64 * (wc >> 1) + 16 * (wc & 1) + 4 * fq;
        { const float* gsrc = (u.pn < 4 ? qgain : kgain) + d0; const f32x4 keep = *(const f32x4*)gsrc; asm volatile("" :: "v"(keep)); }
        if (u.pn < 5) {
#pragma unroll
            for (int ai = 0; ai < 2; ++ai)
#pragma unroll
                for (int m = 0; m < 4; ++m)
#pragma unroll
                    for (int bj = 0; bj < 2; ++bj) { const f32x4 x0 = acc[ai][bj][m][0], x1 = acc[ai][bj][m][1];
                        float ss = (x0[0] * x0[0] + x0[1] * x0[1]) + (x0[2] * x0[2] + x0[3] * x0[3]) + (x1[0] * x1[0] + x1[1] * x1[1]) + (x1[2] * x1[2] + x1[3] * x1[3]);
                        ss += __shfl_xor(ss, 16); ss += __shfl_xor(ss, 32);
                        if (fq == 0) P[(ai * HALF + wr * 64 + m * 16 + fr) * 8 + bj * 4 + wc] = ss; }
        }
        asm volatile("s_waitcnt lgkmcnt(0)" ::: "memory"); __builtin_amdgcn_s_barrier(); asm volatile("" ::: "memory");
        const f32x4 g0 = *(const f32x4*)((u.pn < 4 ? qgain : kgain) + d0), g1 = *(const f32x4*)((u.pn < 4 ? qgain : kgain) + d0 + 32);
        const int fbase = 16 * (wc & 1) + 4 * fq;
        float ifr[4];
#pragma unroll
        for (int j = 0; j < 4; ++j) ifr[j] = __builtin_amdgcn_exp2f(-(float)(fbase + j) * (13.287712379549449f / 32.0f)) * 0.15915494309189535f;
#pragma unroll
        for (int ai = 0; ai < 2; ++ai)
#pragma unroll
            for (int m = 0; m < 4; ++m) {
                const int rl = ai * HALF + wr * 64 + m * 16 + fr;
                float cs[4], sn[4];
                if (u.pn < 5 && lat) { const int t = (jt - 1) * 256 + rl; const float pos = (float)((wc >> 1) ? (t & 63) : (t >> 6));
#pragma unroll
                    for (int j = 0; j < 4; ++j) { const float a = pos * ifr[j], r = a - floorf(a); cs[j] = __builtin_amdgcn_cosf(r); sn[j] = __builtin_amdgcn_sinf(r); } }
                else {
#pragma unroll
                    for (int j = 0; j < 4; ++j) { cs[j] = 1.f; sn[j] = 0.f; } }
#pragma unroll
                for (int bj = 0; bj < 2; ++bj) {
                    f32x4 x0 = acc[ai][bj][m][0], x1 = acc[ai][bj][m][1];
                    if (u.pn < 5) { const f32x4 pp = *(const LAS f32x4*)(P + rl * 8 + bj * 4); const float rstd = rsqrtf(((pp[0] + pp[1]) + (pp[2] + pp[3])) * (1.0f / 128.0f) + NORM_EPS);
                        x0 = x0 * rstd * g0; x1 = x1 * rstd * g1;
                        f32x4 o0, o1;
#pragma unroll
                        for (int j = 0; j < 4; ++j) { o0[j] = x0[j] * cs[j] - x1[j] * sn[j]; o1[j] = x1[j] * cs[j] + x0[j] * sn[j]; }
                        x0 = o0; x1 = o1; }
                    if (u.pn < 5) {
                        unsigned char* dst = (u.pn < 4) ? (unsigned char*)Qb + (((size_t)(b * 8 + 2 * u.pn + bj) * LSEQ) + (size_t)(jt - 1) * 256 + rl) * 128 : (unsigned char*)Kb + (((size_t)(b * 2 + bj) * TBR) + (size_t)jt * 256 + rl) * 128;
                        u32x2 q8; q8.x = pk_fp8x4(x0[0] * 16.f, x0[1] * 16.f, x0[2] * 16.f, x0[3] * 16.f); q8.y = pk_fp8x4(x1[0] * 16.f, x1[1] * 16.f, x1[2] * 16.f, x1[3] * 16.f);
                        *(u32x2*)(dst + 32 * wc + 8 * fq) = q8;
                    } else {
                        unsigned char* dst = (unsigned char*)Vb + (((size_t)(b * 2 + bj) * TBR) + (size_t)jt * 256 + rl) * 128 + d0;
                        *(unsigned*)dst = pk_fp8x4(x0[0] * 16.f, x0[1] * 16.f, x0[2] * 16.f, x0[3] * 16.f); *(unsigned*)(dst + 32) = pk_fp8x4(x1[0] * 16.f, x1[1] * 16.f, x1[2] * 16.f, x1[3] * 16.f); }
                }
            }
    }
};
struct QkvOrder {
    const char* A; const char* Bt; int G, c; size_t tstep;
    __device__ __forceinline__ bool next(int i, Unit& u) const {
        constexpr int nwg = 400; const long L = (long)i * G + c; if (L >= nwg) return false;
        int wgid = (int)L; { const int q = nwg / NXCD, r = nwg % NXCD, xcd = wgid % NXCD, off = wgid / NXCD; wgid = (xcd < r ? xcd * (q + 1) : r * (q + 1) + (xcd - r) * q) + off; }
        int pm, pn;
        if (wgid < 256) { const int pl = wgid >> 2; pn = wgid & 3; pm = (pl >> 3) * 9 + 1 + (pl & 7); } else { const int idx = wgid - 256; pm = idx >> 1; pn = 4 + (idx & 1); }
        u.pm = pm; u.pn = pn; u.aux = 0; u.rl = nullptr; u.nvalid = 256; u.A = A + (size_t)pm * tstep; u.B = Bt + (size_t)pn * tstep; return true;
    }
};
template <int MODE> struct EpiResid {
    static constexpr bool PERM = true, NEEDS_DRAIN = false; static __device__ __forceinline__ int browh(int R, int) { return (R & ~31) + perm32(R & 31); }
    const float* xin; const float* cin; const bf16_t* base1; const float* mod; bf16_t* out;
    __device__ __forceinline__ void operator()(const f32x4 (&acc)[2][2][4][2], const Unit& u, int wr, int wc, int fr, int fq) const {
        const float* base = nullptr; const float* gate;
        if (MODE == 0) { const int b = u.pm / 9, j = u.pm - 9 * b; base = (j == 0) ? cin + (size_t)b * CTXL * DM : xin + ((size_t)b * LSEQ + (size_t)(j - 1) * 256) * DM; gate = mod + (size_t)((j == 0) ? 8 : b) * 6144 + 2048; }
        else { gate = mod + (size_t)(9 + u.pm / 8) * 6144 + 2048; }
        const int rl0 = wr * 64 + fr, col0 = u.pn * BM + wc * 32 + 8 * fq;
        f32x4 gv[2][2];
#pragma unroll
        for (int bj = 0; bj < 2; ++bj)
#pragma unroll
            for (int n = 0; n < 2; ++n) gv[bj][n] = *(const f32x4*)(gate + col0 + bj * HALF + 4 * n);
#pragma unroll
        for (int ai = 0; ai < 2; ++ai)
#pragma unroll
            for (int m = 0; m < 4; ++m) { const int rl = rl0 + ai * HALF + m * 16; const size_t ro = ((size_t)u.pm * 256 + rl) * DM + col0;
#pragma unroll
                for (int bj = 0; bj < 2; ++bj) { f32x4 b0, b1;
                    if (MODE == 0) { const float* bp = base + (size_t)rl * DM + col0 + bj * HALF; b0 = *(const f32x4*)bp; b1 = *(const f32x4*)(bp + 4); }
                    else { const u32x4 bw = *(const u32x4*)(base1 + ro + bj * HALF); b0 = (f32x4){bf_lo(bw.x), bf_hi(bw.x), bf_lo(bw.y), bf_hi(bw.y)}; b1 = (f32x4){bf_lo(bw.z), bf_hi(bw.z), bf_lo(bw.w), bf_hi(bw.w)}; }
                    const f32x4 v0 = b0 + gv[bj][0] * acc[ai][bj][m][0], v1 = b1 + gv[bj][1] * acc[ai][bj][m][1];
                    u32x4 w; w.x = cvt_pk_bf16(v0[0], v0[1]); w.y = cvt_pk_bf16(v0[2], v0[3]); w.z = cvt_pk_bf16(v1[0], v1[1]); w.w = cvt_pk_bf16(v1[2], v1[3]);
                    *(u32x4*)(out + ro + bj * HALF) = w; } }
    }
};
struct EpiSwiglu {
    static constexpr bool PERM = true, NEEDS_DRAIN = false; static __device__ __forceinline__ int browh(int R, int) { return (R & ~31) + perm32(R & 31); }
    unsigned char* O; const float* bias;
    static __device__ __forceinline__ f32x2 sw2(f32x2 g, f32x2 u) {
        g.x = fminf(g.x, 7.0f); g.y = fminf(g.y, 7.0f); u.x = __builtin_amdgcn_fmed3f(u.x, -7.0f, 7.0f); u.y = __builtin_amdgcn_fmed3f(u.y, -7.0f, 7.0f);
        const f32x2 t = g * (-1.702f * 1.4426950408889634f); f32x2 e; e.x = __builtin_amdgcn_exp2f(t.x); e.y = __builtin_amdgcn_exp2f(t.y);
        const f32x2 d = e + 1.0f; f32x2 r; r.x = __builtin_amdgcn_rcpf(d.x); r.y = __builtin_amdgcn_rcpf(d.y);
        return (g * r) * (u * F8_SA + F8_SA);
    }
    __device__ __forceinline__ void operator()(const f32x4 (&acc)[2][2][4][2], const Unit& u, int wr, int wc, int fr, int fq) const {
        const int row0 = u.pm * BM + wr * 64 + fr, cl = wc * 32 + 8 * fq, col0 = u.pn * 128 + cl;
        const float* bb = bias + (size_t)u.aux * 2048 + col0;
        f32x4 bg[2], bu[2];
#pragma unroll
        for (int n = 0; n < 2; ++n) { bg[n] = *(const f32x4*)(bb + 4 * n); bu[n] = *(const f32x4*)(bb + 1024 + 4 * n); }
#pragma unroll
        for (int ai = 0; ai < 2; ++ai)
#pragma unroll
            for (int m = 0; m < 4; ++m) { unsigned char* rowp = O + (size_t)(row0 + ai * HALF + m * 16) * 1024 + col0; u32x2 w;
#pragma unroll
                for (int n = 0; n < 2; ++n) { const f32x4 g4 = acc[ai][0][m][n] + bg[n], u4 = acc[ai][1][m][n] + bu[n];
                    const f32x2 a = sw2((f32x2){g4[0], g4[1]}, (f32x2){u4[0], u4[1]}), c = sw2((f32x2){g4[2], g4[3]}, (f32x2){u4[2], u4[3]});
                    int pk = __builtin_amdgcn_cvt_pk_fp8_f32(a.x, a.y, 0, false); pk = __builtin_amdgcn_cvt_pk_fp8_f32(c.x, c.y, pk, true);
                    w[n] = (unsigned)pk; }
                *(u32x2*)rowp = w; }
    }
};
}

struct MoeOrder {
    const char* A; const char* W; const LAS int* tb; const LAS int* cnt; const int* list; int nM, NPN, G, c; size_t tstepA, wstride, pnstride;
    __device__ __forceinline__ bool next(int i, pg8::Unit& u) const {
        const int nwg = nM * NPN; const long L = (long)i * G + c; if (L >= nwg) return false;
        int wgid = (int)L; { const int q = nwg / 8, r = nwg % 8, xcd = wgid % 8, off = wgid / 8; wgid = (xcd < r ? xcd * (q + 1) : r * (q + 1) + (xcd - r) * q) + off; }
        const int mt = wgid / NPN, pn = wgid - mt * NPN;
        int e = 0;
        for (int j = 1; j < NE; ++j) e += (tb[j] <= mt) ? 1 : 0;
        e = __builtin_amdgcn_readfirstlane(e);
        const int r0 = (mt - __builtin_amdgcn_readfirstlane(tb[e])) * 256, left = __builtin_amdgcn_readfirstlane(cnt[e]) - r0;
        u.pm = mt; u.pn = pn; u.aux = e; u.nvalid = left < 256 ? left : 256; u.rl = list ? list + (size_t)e * ECAP + r0 : nullptr;
        u.A = list ? A : A + (size_t)mt * tstepA; u.B = W + (size_t)e * wstride + (size_t)pn * pnstride; return true;
    }
};

namespace att {
constexpr int D = 128, NW = 8, QBLK = 32, KVBLK = 64;
constexpr float SCALE = 0.088388347648318440f;
constexpr float THR = 4.f;
constexpr int LDQ = 128, LDK = 128, LDO = 1024;
constexpr int VROW = 80;
constexpr size_t SHM_V = D * VROW, SHM_K = KVBLK * D, SHM_ATTN = 5 * SHM_V + 5 * SHM_K + NW * 64 * 4;
constexpr int QK_SC = 0x7b7b7b7b;
constexpr int P_SC = 0x7c7c7c7c;
#define KSWZ8(row, c) ((row) * 128 + ((((c) ^ ((row) & 7))) << 4))
#define SBAR() __builtin_amdgcn_sched_barrier(0)
__device__ __forceinline__ int crow(int r, int hi) { return (r & 3) + 8 * (r >> 2) + 4 * hi; }
__device__ __forceinline__ void partialSM(f32x16& p0, f32x16& p1, float& m_reg, float& mn, float& alpha) {
  constexpr float C = SCALE * 1.4426950408889634f;
  float pmax = p0[0];
#pragma unroll
  for (int r = 1; r < 16; ++r) pmax = fmaxf(pmax, p0[r]);
#pragma unroll
  for (int r = 0; r < 16; ++r) pmax = fmaxf(pmax, p1[r]);
  { auto rr = __builtin_amdgcn_permlane32_swap(__float_as_uint(pmax), __float_as_uint(pmax), false, false);
    pmax = fmaxf(__uint_as_float(rr[0]), __uint_as_float(rr[1])); }
  if (__builtin_expect(__all(pmax - m_reg <= THR / SCALE), 1)) { mn = m_reg; alpha = 1.f; }
  else { mn = fmaxf(m_reg, pmax); alpha = __builtin_amdgcn_exp2f((m_reg - mn) * C); m_reg = mn; }
  float mnC = 3.0f - mn * C;
#pragma unroll
  for (int r = 0; r < 16; ++r) p0[r] = fmaf(p0[r], C, mnC);
#pragma unroll
  for (int r = 0; r < 16; ++r) p1[r] = fmaf(p1[r], C, mnC);
#pragma unroll
  for (int r = 0; r < 16; ++r) p0[r] = __builtin_amdgcn_exp2f(p0[r]);
}
__device__ __forceinline__ void finishSM(f32x16& p0, f32x16& p1, float alpha, float& l_reg, i32x8& pa) {
#pragma unroll
  for (int r = 0; r < 16; ++r) p1[r] = __builtin_amdgcn_exp2f(p1[r]);
  float ps = 0;
#pragma unroll
  for (int r = 0; r < 16; ++r) ps += p0[r];
#pragma unroll
  for (int r = 0; r < 16; ++r) ps += p1[r];
  { auto rr = __builtin_amdgcn_permlane32_swap(__float_as_uint(ps), __float_as_uint(ps), false, false);
    ps = __uint_as_float(rr[0]) + __uint_as_float(rr[1]); }
  l_reg = l_reg * alpha + ps * 0.125f;
  pa[0] = (int)pk_fp8x4_nc(p0[0], p0[1], p0[2], p0[3]);   pa[1] = (int)pk_fp8x4_nc(p0[4], p0[5], p0[6], p0[7]);
  pa[2] = (int)pk_fp8x4_nc(p0[8], p0[9], p0[10], p0[11]); pa[3] = (int)pk_fp8x4_nc(p0[12], p0[13], p0[14], p0[15]);
  pa[4] = (int)pk_fp8x4_nc(p1[0], p1[1], p1[2], p1[3]);   pa[5] = (int)pk_fp8x4_nc(p1[4], p1[5], p1[6], p1[7]);
  pa[6] = (int)pk_fp8x4_nc(p1[8], p1[9], p1[10], p1[11]); pa[7] = (int)pk_fp8x4_nc(p1[12], p1[13], p1[14], p1[15]);
}
__device__ __forceinline__ void qkt(f32x16& p0, f32x16& p1, const unsigned char* Ks, const i32x8* qr, int r32, int hi) {
  p0 = f32x16{}; p1 = f32x16{};
#pragma unroll
  for (int m = 0; m < 2; ++m) { const int c0 = 4 * m + 2 * hi;
    const i32x4 a0 = *reinterpret_cast<const i32x4*>(Ks + KSWZ8(r32, c0)), a1 = *reinterpret_cast<const i32x4*>(Ks + KSWZ8(r32, c0 + 1));
    const i32x4 b0 = *reinterpret_cast<const i32x4*>(Ks + KSWZ8(32 + r32, c0)), b1 = *reinterpret_cast<const i32x4*>(Ks + KSWZ8(32 + r32, c0 + 1));
    const i32x8 ka = __builtin_shufflevector(a0, a1, 0, 1, 2, 3, 4, 5, 6, 7), kb = __builtin_shufflevector(b0, b1, 0, 1, 2, 3, 4, 5, 6, 7);
    p0 = __builtin_amdgcn_mfma_scale_f32_32x32x64_f8f6f4(ka, qr[m], p0, 0, 0, 0, QK_SC, 0, QK_SC);
    p1 = __builtin_amdgcn_mfma_scale_f32_32x32x64_f8f6f4(kb, qr[m], p1, 0, 0, 0, QK_SC, 0, QK_SC); }
}
__device__ __forceinline__ void pv_d0(f32x16* o, const unsigned char* Vt, const i32x8& pa, int r32, int hi) {
  const unsigned char* vb = Vt + r32 * VROW + 32 * hi;
#pragma unroll
  for (int d0 = 0; d0 < 4; ++d0) {
    const i32x4 b0 = *reinterpret_cast<const i32x4*>(vb + d0 * 32 * VROW), b1 = *reinterpret_cast<const i32x4*>(vb + d0 * 32 * VROW + 16);
    const i32x8 vv = __builtin_shufflevector(b0, b1, 0, 1, 2, 3, 4, 5, 6, 7);
    o[d0] = __builtin_amdgcn_mfma_scale_f32_32x32x64_f8f6f4(pa, vv, o[d0], 0, 0, 0, P_SC, 0, QK_SC); }
}
__device__ __forceinline__ void attn_dense_body(const unsigned char* __restrict__ Qb, const unsigned char* __restrict__ Kh, const unsigned char* __restrict__ Vh, bf16_t* __restrict__ Ob, int seq, char* lds) {
  const int tid = threadIdx.x, wid = tid >> 6, lane = tid & 63, r32 = lane & 31, hi = lane >> 5;
  unsigned char* V_lds = (unsigned char*)lds; unsigned char* K_lds = (unsigned char*)(lds + 5 * SHM_V);
  float* ws = (float*)(lds + 5 * SHM_V + 5 * SHM_K) + wid * 64; float* li_l = ws; float* al_l = ws + 32;
  float m_reg = -1e30f, l_reg = 0; f32x16 o[4] = {}; i32x8 qr[2];
  const unsigned char* Qw = Qb + (unsigned)(wid * QBLK + r32) * 128u + hi * 32;
#pragma unroll
  for (int m = 0; m < 2; ++m) { const i32x4 q0 = *reinterpret_cast<const i32x4*>(Qw + 64 * m), q1 = *reinterpret_cast<const i32x4*>(Qw + 64 * m + 16); qr[m] = __builtin_shufflevector(q0, q1, 0, 1, 2, 3, 4, 5, 6, 7); }
  const int vq = (lane & 7) + 8 * (wid & 3), a4 = (lane >> 3) + 8 * (wid >> 2);
  const unsigned vo = (unsigned)(4 * a4) * 128u + 4u * vq;
  const int vpos = 32 * (a4 & 1) + 16 * (a4 >> 3) + 4 * ((a4 >> 1) & 3);
  const int vst = 4 * vq * VROW + vpos;
  struct { u32x4 vs; bf16x8 ks0; } sr_[2];
  const unsigned kk = (unsigned)(tid >> 3), kch = (unsigned)(tid & 7), ko8 = kk * 128u + kch * 16u;
#define SLOAD(i, k0) do { const unsigned char* vb_ = Vh + (unsigned)(k0) * 128u; const unsigned char* kb_ = Kh + (unsigned)(k0) * 128u; \
    sr_[i].vs[0] = *reinterpret_cast<const unsigned*>(vb_ + vo); sr_[i].vs[1] = *reinterpret_cast<const unsigned*>(vb_ + vo + 128u); \
    sr_[i].vs[2] = *reinterpret_cast<const unsigned*>(vb_ + vo + 256u); sr_[i].vs[3] = *reinterpret_cast<const unsigned*>(vb_ + vo + 384u); \
    sr_[i].ks0 = *reinterpret_cast<const bf16x8*>(kb_ + ko8); } while (0)
#define SWRITE(b, i) do { const u32x4 r_ = sr_[i].vs;                                                                                          \
    const unsigned t0_ = __builtin_amdgcn_perm(r_[1], r_[0], 0x05010400u), t1_ = __builtin_amdgcn_perm(r_[1], r_[0], 0x07030602u);            \
    const unsigned t2_ = __builtin_amdgcn_perm(r_[3], r_[2], 0x05010400u), t3_ = __builtin_amdgcn_perm(r_[3], r_[2], 0x07030602u);            \
    unsigned char* vd_ = V_lds + (b) * SHM_V + vst;                                                                                            \
    *(unsigned*)(vd_) = __builtin_amdgcn_perm(t2_, t0_, 0x05040100u); *(unsigned*)(vd_ + VROW) = __builtin_amdgcn_perm(t2_, t0_, 0x07060302u); \
    *(unsigned*)(vd_ + 2 * VROW) = __builtin_amdgcn_perm(t3_, t1_, 0x05040100u); *(unsigned*)(vd_ + 3 * VROW) = __builtin_amdgcn_perm(t3_, t1_, 0x07060302u); \
    *(bf16x8*)((char*)K_lds + (b) * SHM_K + KSWZ8(kk, kch)) = sr_[i].ks0; } while (0)
#define RESC(a) do { if (__any((a) < 1.f)) { if (hi == 0) al_l[r32] = (a); asm volatile("s_waitcnt lgkmcnt(0)" ::: "memory"); \
    _Pragma("unroll") for (int d = 0; d < 4; ++d) _Pragma("unroll") for (int r = 0; r < 16; ++r) o[d][r] *= al_l[crow(r, hi)]; } } while (0)
#define STEP(PX0, PX1, ALX, PY0, PY1, MNY, ALY, J, W, L, Q, BAR) do {                                                    \
    if (W) { asm volatile("s_waitcnt vmcnt(0)" ::: "memory"); SWRITE(sW, 0); if (L) SLOAD(0, ((J) + 4) * KVBLK); }       \
    SBAR(); if (Q) qkt(PY0, PY1, K_lds + sK * SHM_K, qr, r32, hi);                                                       \
    finishSM(PX0, PX1, ALX, l_reg, pa); SBAR();                                                                          \
    pv_d0(o, V_lds + sV * SHM_V, pa, r32, hi);                                                                           \
    if (Q) { partialSM(PY0, PY1, m_reg, MNY, ALY); RESC(ALY); }                                                          \
    if (BAR) __syncthreads();                                                                                            \
    sV = sK; sK = (sK == 4) ? 0 : sK + 1; sW = (sW == 4) ? 0 : sW + 1; } while (0)
  f32x16 pA0, pA1, pB0, pB1; float mnA, mnB, alA, alB; i32x8 pa; const int NT = seq / KVBLK;
  int sV = 0, sK = 1, sW = 3;
  SLOAD(0, 0); SLOAD(1, KVBLK); asm volatile("s_waitcnt vmcnt(0)" ::: "memory"); SWRITE(0, 0); SWRITE(1, 1);
  SLOAD(1, 2 * KVBLK); SLOAD(0, 3 * KVBLK); asm volatile("s_waitcnt vmcnt(5)" ::: "memory"); SWRITE(2, 1); __syncthreads();
  qkt(pA0, pA1, K_lds, qr, r32, hi); partialSM(pA0, pA1, m_reg, mnA, alA);
  int j = 0;
  for (; j + 5 < NT; j += 2) {
    STEP(pA0, pA1, alA, pB0, pB1, mnB, alB, j, true, true, true, false);
    STEP(pB0, pB1, alB, pA0, pA1, mnA, alA, j + 1, true, true, true, true);
  }
  STEP(pA0, pA1, alA, pB0, pB1, mnB, alB, j, true, false, true, false);
  STEP(pB0, pB1, alB, pA0, pA1, mnA, alA, j + 1, false, false, true, true);
  STEP(pA0, pA1, alA, pB0, pB1, mnB, alB, j + 2, false, false, true, false);
  STEP(pB0, pB1, alB, pA0, pA1, mnA, alA, j + 3, false, false, false, false);
  if (hi == 0) li_l[r32] = l_reg; asm volatile("s_waitcnt lgkmcnt(0)" ::: "memory");
  float rli[16];
#pragma unroll
  for (int r = 0; r < 16; ++r) rli[r] = __builtin_amdgcn_rcpf(li_l[crow(r, hi)]);
  bf16_t* Ow = Ob + (long)(wid * QBLK) * LDO;
#pragma unroll
  for (int r = 0; r < 16; ++r) { int orow = crow(r, hi);
#pragma unroll
    for (int d0 = 0; d0 < 4; ++d0) Ow[(long)orow * LDO + d0 * 32 + r32] = (bf16_t)(cvt_pk_bf16(o[d0][r] * rli[r], 0.f) & 0xffffu); }
  __syncthreads();
#undef SLOAD
#undef SWRITE
#undef STEP
#undef RESC
}
}

struct Ctx {
    LAS unsigned char* lds; int tid, lane, wave, G, bid;
};

__device__ __forceinline__ void ada_phase(const Params& P, const Ctx& F) {
    LAS float* S = (LAS float*)F.lds;
    LAS float* red = (LAS float*)(F.lds + 36864);
    float* mod = (float*)(P.ws + WS_MOD);
    for (int i = F.tid; i < 9 * 1024; i += NTHREADS) { const float v = (i < 8192) ? P.c[i] : P.c_ctx[i - 8192]; S[i] = v / (1.0f + __expf(-v)); }
    __syncthreads();
    const int kg = F.tid >> 3, cq = F.tid & 7;
    for (int u = F.bid; u < 384; u += F.G) {
        const int l = u / 192, n0 = (u - l * 192) * 32;
        const float* W = P.ada_w + (size_t)l * 1024 * 6144 + n0 + cq * 4;
        float acc[9][4];
#pragma unroll
        for (int r = 0; r < 9; ++r)
#pragma unroll
            for (int j = 0; j < 4; ++j) acc[r][j] = 0.f;
#pragma unroll 4
        for (int it = 0; it < 16; ++it) {
            const int k = kg + 64 * it;
            const f32x4 w = *(const f32x4*)(W + (size_t)k * 6144);
#pragma unroll
            for (int r = 0; r < 9; ++r) { const float s = S[r * 1024 + k];
#pragma unroll
                for (int j = 0; j < 4; ++j) acc[r][j] = fmaf(s, w[j], acc[r][j]); }
        }
#pragma unroll
        for (int r = 0; r < 9; ++r)
#pragma unroll
            for (int j = 0; j < 4; ++j) red[kg * 288 + r * 32 + cq * 4 + j] = acc[r][j];
        __syncthreads();
        if (F.tid < 288) { float s = 0.f; for (int g = 0; g < 64; ++g) s += red[g * 288 + F.tid];
            const int r = F.tid >> 5, col = F.tid & 31; mod[((size_t)l * 9 + r) * 6144 + n0 + col] = s + P.ada_b[l * 6144 + n0 + col]; }
        __syncthreads();
    }
}

constexpr int CVT_T0 = 512, CVT_T1 = CVT_T0 + 256, CVT_T2 = CVT_T1 + 192, CVT_T3 = CVT_T2 + 128, CVT_T4 = CVT_T3 + 64 * 256, CVT_T5 = CVT_T4 + 64 * 128;
struct CvtTile { const float* src; unsigned char* dst; int K, N, f8; };
struct CvtTile8 { const float* src; unsigned char* dst; int N; };
__device__ __forceinline__ void cvt_decode_moe(const Params& P, int ql, int j, CvtTile8& d) {
    const bool gu = j < 4096; const int loc = gu ? j : j - 4096, N = gu ? 2048 : 1024, ntn = N / 128, tpm = 8 * ntn;
    const int m = loc / tpm, rem = loc - m * tpm, kt = rem / ntn, nt = rem - kt * ntn, mm = ql * 32 + m;
    size_t sdiff = (size_t)((uintptr_t)P.w_dn - (uintptr_t)P.w_gu); asm volatile("" : "+s"(sdiff));
    const float* src = (const float*)((uintptr_t)P.w_gu + (gu ? (size_t)0 : sdiff)); const size_t dof = gu ? WS_WGU : WS_WDN;
    d.src = src + (size_t)mm * 1024 * N + (size_t)kt * 128 * N + nt * 128; d.dst = P.ws + dof + (size_t)mm * 1024 * N + (size_t)nt * 128 * 1024 + kt * 128; d.N = N;
}
__device__ __forceinline__ void cvt_load8(const CvtTile8& d, int tid, f32x4 (&r)[8]) {
#pragma unroll
    for (int j = 0; j < 8; ++j) { const int idx = tid + 512 * j; r[j] = __builtin_nontemporal_load((const f32x4*)(d.src + (size_t)(idx >> 5) * d.N + (idx & 31) * 4)); }
}
__device__ __forceinline__ void cvt_tile8(const CvtTile8& d, int tid, const f32x4 (&cur)[8], LAS float* L) {
#pragma unroll
    for (int j = 0; j < 8; ++j) { const int idx = tid + 512 * j, k = idx >> 5, c4 = idx & 31; *(LAS f32x4*)(L + ((k >> 4) + 8 * (k & 15)) * 132 + 4 * c4) = cur[j]; }
    __syncthreads();
    {
#pragma unroll
    for (int j = 0; j < 2; ++j) { const int kg = tid & 7, n = (tid >> 3) + 64 * j; const LAS float* q = L + kg * 132 + n; float v[16];
#pragma unroll
        for (int jj = 0; jj < 16; ++jj) v[jj] = q[jj * 8 * 132] * F8_SW;
        u32x4 w; w.x = pk_fp8x4(v[0], v[1], v[2], v[3]); w.y = pk_fp8x4(v[4], v[5], v[6], v[7]); w.z = pk_fp8x4(v[8], v[9], v[10], v[11]); w.w = pk_fp8x4(v[12], v[13], v[14], v[15]);
        __builtin_nontemporal_store(w, (u32x4*)(d.dst + (size_t)n * 1024 + 16 * kg)); } }
    __syncthreads();
}
__device__ __forceinline__ int cvt_kperm(int k) { return 2 * (k >> 3) + (k & 1) + 32 * ((k & 7) >> 1); }
__device__ __forceinline__ void cvt_load(const CvtTile& d, int tid, f32x4 (&r)[4]) {
#pragma unroll
    for (int j = 0; j < 4; ++j) { const int idx = tid + 512 * j; r[j] = *(const f32x4*)(d.src + (size_t)(idx >> 4) * d.N + (idx & 15) * 4); }
}
__device__ __forceinline__ void cvt_tile(const CvtTile& d, int tid, const f32x4 (&cur)[4], LAS float* L) {
#pragma unroll
    for (int j = 0; j < 4; ++j) { const int idx = tid + 512 * j, k = idx >> 4, c4 = idx & 15; LAS float* p = L + cvt_kperm(k) * 65 + 4 * c4;
        p[0] = cur[j][0]; p[1] = cur[j][1]; p[2] = cur[j][2]; p[3] = cur[j][3]; }
    __syncthreads();
    if (d.f8) { const int kg = tid & 7, n = tid >> 3; float v[16];
#pragma unroll
        for (int jj = 0; jj < 16; ++jj) v[jj] = L[cvt_kperm(16 * kg + jj) * 65 + n] * F8_SW;
        u32x4 w; w.x = pk_fp8x4(v[0], v[1], v[2], v[3]); w.y = pk_fp8x4(v[4], v[5], v[6], v[7]); w.z = pk_fp8x4(v[8], v[9], v[10], v[11]); w.w = pk_fp8x4(v[12], v[13], v[14], v[15]);
        *(u32x4*)(d.dst + (size_t)n * d.K + 16 * kg) = w; }
    else {
#pragma unroll
        for (int j = 0; j < 2; ++j) { const int kg = tid & 15, n = (tid >> 4) + 32 * j; float v[8];
#pragma unroll
            for (int jj = 0; jj < 8; ++jj) v[jj] = L[cvt_kperm(8 * kg + jj) * 65 + n];
            u32x4 w; w.x = cvt_pk_bf16(v[0], v[1]); w.y = cvt_pk_bf16(v[2], v[3]); w.z = cvt_pk_bf16(v[4], v[5]); w.w = cvt_pk_bf16(v[6], v[7]);
            *(u32x4*)(d.dst + ((size_t)n * d.K + 8 * kg) * 2) = w; } }
    __syncthreads();
}
constexpr int CVT_QN = 4096 + 2048;
__device__ __forceinline__ void cvt_fill(const Params& P, const Ctx& F, int ql, const unsigned* done, int need) {
    LAS float* L = (LAS float*)F.lds;
    LAS int* mb = (LAS int*)(F.lds + 69632);
    unsigned* head = (unsigned*)(P.ws + WS_QHEAD + ql * 256);
    constexpr int LIM = CVT_QN;
    int i0, i1, i2; bool stop = false;
    __syncthreads();
    if (F.tid == 0) mb[0] = (int)__hip_atomic_fetch_add(head, 3u, __ATOMIC_RELAXED, __HIP_MEMORY_SCOPE_AGENT);
    __syncthreads();
    i0 = mb[0]; i1 = i0 + 1; i2 = i0 + 2;
    if (i0 >= LIM) return;
    f32x4 r0[8], r1[8], r2[8]; CvtTile8 d0, d1, d2;
    cvt_decode_moe(P, ql, i0, d0); cvt_load8(d0, F.tid, r0);
    d1 = d0; d2 = d0;
    if (i1 < LIM) { cvt_decode_moe(P, ql, i1, d1); cvt_load8(d1, F.tid, r1); }
    for (;;) {
        int i3 = LIM, st = 0;
        if (F.tid == 0 && i2 < LIM && !stop) { i3 = (int)__hip_atomic_fetch_add(head, 1u, __ATOMIC_RELAXED, __HIP_MEMORY_SCOPE_AGENT); if (need >= 0) st = (int)__hip_atomic_load(done, __ATOMIC_RELAXED, __HIP_MEMORY_SCOPE_AGENT) >= need; }
        if (i2 < LIM) { cvt_decode_moe(P, ql, i2, d2); cvt_load8(d2, F.tid, r2); }
        cvt_tile8(d0, F.tid, r0, L);
        if (F.tid == 0) { mb[0] = i3; mb[1] = st; }
        __syncthreads(); i3 = mb[0]; stop = stop || (mb[1] != 0);
        if (i1 >= LIM) break;
        r0[0] = r1[0]; r0[1] = r1[1]; r0[2] = r1[2]; r0[3] = r1[3]; r0[4] = r1[4]; r0[5] = r1[5]; r0[6] = r1[6]; r0[7] = r1[7];
        r1[0] = r2[0]; r1[1] = r2[1]; r1[2] = r2[2]; r1[3] = r2[3]; r1[4] = r2[4]; r1[5] = r2[5]; r1[6] = r2[6]; r1[7] = r2[7];
        d0 = d1; d1 = d2; i0 = i1; i1 = i2; i2 = i3;
    }
}
__device__ __forceinline__ void cvt_dense_one(const Ctx& F, const float* src, unsigned char* dst, int K, int N, int f8 = 0) {
    LAS float* L = (LAS float*)F.lds; const int ntn = N / 64, ntiles = (K / 128) * ntn;
    for (int t = F.bid; t < ntiles; t += F.G) { const int kt = t / ntn, nt = t - kt * ntn; CvtTile d;
        d.src = src + (size_t)kt * 128 * N + nt * 64; d.dst = dst + ((size_t)nt * 64 * K + kt * 128) * (f8 ? 1 : 2); d.K = K; d.N = N; d.f8 = f8;
        f32x4 r[4]; cvt_load(d, F.tid, r); cvt_tile(d, F.tid, r, L); }
}
__device__ __forceinline__ void cvt_phase(const Params& P, const Ctx& F) {
    { bf16_t* rh = (bf16_t*)(P.ws + WS_RWH); bf16_t* rl = (bf16_t*)(P.ws + WS_RWL);
      for (int i = F.bid * NTHREADS + F.tid; i < 2 * 1024 * 32; i += F.G * NTHREADS) {
          const int l = i >> 15, k = (i >> 5) & 1023, e = i & 31; const float w = P.router_w[i];
          const unsigned h = cvt_pk_bf16(w, 0.f) & 0xffffu; const float rem = w - __uint_as_float(h << 16);
          rh[(l * 32 + e) * 1024 + k] = (bf16_t)h; rl[(l * 32 + e) * 1024 + k] = (bf16_t)(cvt_pk_bf16(rem, 0.f) & 0xffffu); } }
    cvt_dense_one(F, P.gm_w_in, P.ws + WS_WIN, 1024, 4096); cvt_dense_one(F, P.gm_w_out, P.ws + WS_WOUT, 2048, 1024);
    cvt_dense_one(F, P.at_w_qkv, P.ws + WS_WQKV, 1024, 1536, 1); cvt_dense_one(F, P.at_w_o, P.ws + WS_WO, 1024, 1024);
}
__device__ __forceinline__ void tail_fill(const Params& P, const Ctx& F, int ql, int phase, int nwg) {
    unsigned* done = (unsigned*)(P.ws + WS_PHDONE + phase * 256);
    const int G = F.G, nlong = nwg % G;
    if (nlong == 0) return;
    if (F.bid < nlong) { if (F.tid == 0) __hip_atomic_fetch_add(done, 1u, __ATOMIC_RELAXED, __HIP_MEMORY_SCOPE_AGENT); }
    else cvt_fill(P, F, ql, done, nlong);
}

__device__ __forceinline__ void norm0_phase(const Params& P, const Ctx& F) {
    const float* mod = (const float*)(P.ws + WS_MOD); bf16_t* hb = (bf16_t*)(P.ws + WS_HBUF);
    const int nwaves = F.G * 8, rpw = (T + nwaves - 1) / nwaves;
    const int rbeg = (F.bid * 8 + F.wave) * rpw, rend = (rbeg + rpw < T) ? rbeg + rpw : T;
    if (rbeg >= rend) return;
    f32x4 gv[4], scv[4], shv[4]; int cur_mr = -1;
    f32x4 xn[4];
#define N0_LOAD(R) do { const float* src_ = src_row(P, (R)); _Pragma("unroll") for (int j = 0; j < 2; ++j) { xn[2 * j] = *(const f32x4*)(src_ + 8 * F.lane + 512 * j); xn[2 * j + 1] = *(const f32x4*)(src_ + 8 * F.lane + 512 * j + 4); } } while (0)
    N0_LOAD(rbeg);
    for (int r = rbeg; r < rend; ++r) {
        f32x4 v[4]; float ss = 0.f;
#pragma unroll
        for (int j = 0; j < 4; ++j) { v[j] = xn[j]; ss += (v[j][0] * v[j][0] + v[j][1] * v[j][1]) + (v[j][2] * v[j][2] + v[j][3] * v[j][3]); }
        const int mr = mod_row(r);
        if (mr != cur_mr) { cur_mr = mr; const float* md = mod + (size_t)mr * 6144;
#pragma unroll
            for (int j = 0; j < 4; ++j) { const int c = 8 * F.lane + 512 * (j >> 1) + 4 * (j & 1); gv[j] = *(const f32x4*)(P.norm_mix + c); scv[j] = *(const f32x4*)(md + 1024 + c) + 1.0f; shv[j] = *(const f32x4*)(md + c); } }
        if (r + 1 < rend) N0_LOAD(r + 1);
        ss = wave_sum(ss); const float rstd = rsqrtf(ss * (1.0f / 1024.0f) + NORM_EPS);
#pragma unroll
        for (int j = 0; j < 2; ++j) { const f32x4 h0 = (v[2 * j] * rstd) * gv[2 * j] * scv[2 * j] + shv[2 * j], h1 = (v[2 * j + 1] * rstd) * gv[2 * j + 1] * scv[2 * j + 1] + shv[2 * j + 1];
            u32x4 w; w.x = cvt_pk_bf16(h0[0], h0[1]); w.y = cvt_pk_bf16(h0[2], h0[3]); w.z = cvt_pk_bf16(h1[0], h1[1]); w.w = cvt_pk_bf16(h1[2], h1[3]);
            *(u32x4*)(hb + (size_t)r * 1024 + 8 * F.lane + 512 * j) = w; }
    }
#undef N0_LOAD
}

template <int OFF> __device__ __forceinline__ s16x4 tr_read_o(int vb) { s16x4 r; asm volatile("ds_read_b64_tr_b16 %0, %1 offset:%2" : "=&v"(r) : "v"(vb), "i"(OFF) : "memory"); return r; }
constexpr int SG_STRIDE = 544;
__device__ __forceinline__ int sg_off(int q, int cbyte) { return q * SG_STRIDE + (cbyte ^ (((q >> 3) & 1) << 7)); }
__device__ __forceinline__ void sgate_phase(const Params& P, const Ctx& F) {
    const bf16_t* uv = (const bf16_t*)(P.ws + WS_UV); const float* vss = (const float*)(P.ws + WS_VSS); bf16_t* tb = (bf16_t*)(P.ws + WS_TBUF);
    LAS unsigned char* Vl = F.lds;
    LAS float* rq = (LAS float*)(F.lds + 128 * SG_STRIDE);
    const int fr = F.lane & 15, fq = F.lane >> 4, pw = F.wave & 3, ch = F.wave >> 2;
    u32x4 vt[8]; float rqn = 0.f;
#define SG_LOADV(U) do { const int _c = (U) >> 3, _g = (U) & 7, _r0 = _c * 128; \
        if (F.tid < 128) { const float* p = vss + (size_t)(_r0 + F.tid) * 32; float s_ = 0.f; \
            _Pragma("unroll") for (int j = 0; j < 8; ++j) { const f32x4 a = *(const f32x4*)(p + 4 * j); s_ += (a[0] + a[1]) + (a[2] + a[3]); } \
            rqn = rsqrtf(s_ * (1.0f / 2048.0f) + NORM_EPS); } \
        _Pragma("unroll") for (int j = 0; j < 8; ++j) { const int idx = F.tid + 512 * j, q = idx >> 5, c16 = idx & 31; \
            vt[j] = *(const u32x4*)(uv + (size_t)(_r0 + q) * 4096 + 2048 + _g * 256 + c16 * 8); } } while (0)
    if (F.bid < 144 * 8) SG_LOADV(F.bid);
    for (int u = F.bid; u < 144 * 8; u += F.G) {
        const int chunk = u >> 3, g = u & 7, r0 = chunk * 128;
        if (F.tid < 128) rq[F.tid] = rqn;
#pragma unroll
        for (int j = 0; j < 8; ++j) { const int idx = F.tid + 512 * j, q = idx >> 5, c16 = idx & 31; *(LAS u32x4*)(Vl + sg_off(q, c16 * 16)) = vt[j]; }
        f32x4 wa[2][4], wb[2][4];
#pragma unroll
        for (int jb = 0; jb < 2; ++jb)
#pragma unroll
            for (int ks = 0; ks < 4; ++ks) { const float* wp = P.gm_w_s + ((size_t)g * 128 + 32 * pw + 16 * jb + fr) * 128 + 32 * ks + 8 * fq; wa[jb][ks] = *(const f32x4*)wp; wb[jb][ks] = *(const f32x4*)(wp + 4); }
        u32x4 uus[2][4]; f32x4 gn0[4], gn1[4]; float bsv[2];
#pragma unroll
        for (int jb = 0; jb < 2; ++jb) { bsv[jb] = P.gm_b_s[g * 128 + 32 * pw + 16 * jb + fr];
#pragma unroll
            for (int c2 = 0; c2 < 4; ++c2) uus[jb][c2] = *(const u32x4*)(uv + (size_t)(r0 + 32 * pw + 16 * jb + fr) * 4096 + g * 256 + 128 * ch + 32 * c2 + 8 * fq); }
#pragma unroll
        for (int c2 = 0; c2 < 4; ++c2) { const int col = g * 256 + 128 * ch + 32 * c2 + 8 * fq; gn0[c2] = *(const f32x4*)(P.gm_v_gain + col); gn1[c2] = *(const f32x4*)(P.gm_v_gain + col + 4); }
        if (u + F.G < 144 * 8) SG_LOADV(u + F.G);
        __syncthreads();
        bf16x8 wf[2][4];
#pragma unroll
        for (int jb = 0; jb < 2; ++jb)
#pragma unroll
            for (int ks = 0; ks < 4; ++ks) { const int q0 = 32 * ks + 8 * fq; const f32x4 a = wa[jb][ks], b = wb[jb][ks];
                const f32x4 ra = *(const LAS f32x4*)(rq + q0), rb = *(const LAS f32x4*)(rq + q0 + 4);
                u32x4 w; w.x = cvt_pk_bf16(a[0] * ra[0], a[1] * ra[1]); w.y = cvt_pk_bf16(a[2] * ra[2], a[3] * ra[3]); w.z = cvt_pk_bf16(b[0] * rb[0], b[1] * rb[1]); w.w = cvt_pk_bf16(b[2] * rb[2], b[3] * rb[3]);
                wf[jb][ks] = *reinterpret_cast<bf16x8*>(&w); }
        f32x4 acc[2][4][2];
#pragma unroll
        for (int jb = 0; jb < 2; ++jb)
#pragma unroll
            for (int c2 = 0; c2 < 4; ++c2)
#pragma unroll
                for (int n = 0; n < 2; ++n) acc[jb][c2][n] = (f32x4){0.f, 0.f, 0.f, 0.f};
        const int qq = fr >> 2, pp = fr & 3;
        const int vbase = (int)(uintptr_t)Vl + (8 * fq + qq) * SG_STRIDE + 256 * ch + 16 * pp;
        const int baseA = vbase + ((fq & 1) ? 128 : 0), baseB = vbase + ((fq & 1) ? 0 : 128);
#define SG_STEP(KS, C2H) do { s16x4 lo[4], hi[4]; const int bs = (C2H) ? baseB : baseA; \
            lo[0] = tr_read_o<(KS) * 32 * SG_STRIDE + 0>(bs);      hi[0] = tr_read_o<(KS) * 32 * SG_STRIDE + 4 * SG_STRIDE + 0>(bs); \
            lo[1] = tr_read_o<(KS) * 32 * SG_STRIDE + 8>(bs);      hi[1] = tr_read_o<(KS) * 32 * SG_STRIDE + 4 * SG_STRIDE + 8>(bs); \
            lo[2] = tr_read_o<(KS) * 32 * SG_STRIDE + 64>(bs);     hi[2] = tr_read_o<(KS) * 32 * SG_STRIDE + 4 * SG_STRIDE + 64>(bs); \
            lo[3] = tr_read_o<(KS) * 32 * SG_STRIDE + 72>(bs);     hi[3] = tr_read_o<(KS) * 32 * SG_STRIDE + 4 * SG_STRIDE + 72>(bs); \
            asm volatile("s_waitcnt lgkmcnt(0)" ::: "memory"); __builtin_amdgcn_sched_barrier(0); \
            _Pragma("unroll") for (int x = 0; x < 4; ++x) { const bf16x8 vf = (bf16x8){lo[x][0], lo[x][1], lo[x][2], lo[x][3], hi[x][0], hi[x][1], hi[x][2], hi[x][3]}; \
                _Pragma("unroll") for (int jb = 0; jb < 2; ++jb) acc[jb][2 * (C2H) + (x >> 1)][x & 1] = __builtin_amdgcn_mfma_f32_16x16x32_bf16(vf, wf[jb][KS], acc[jb][2 * (C2H) + (x >> 1)][x & 1], 0, 0, 0); } } while (0)
        SG_STEP(0, 0); SG_STEP(0, 1); SG_STEP(1, 0); SG_STEP(1, 1); SG_STEP(2, 0); SG_STEP(2, 1); SG_STEP(3, 0); SG_STEP(3, 1);
#undef SG_STEP
#pragma unroll
        for (int jb = 0; jb < 2; ++jb) { const int p = 32 * pw + 16 * jb + fr; const float bs = bsv[jb];
#pragma unroll
            for (int c2 = 0; c2 < 4; ++c2) { const int col = g * 256 + 128 * ch + 32 * c2 + 8 * fq;
                const f32x4 g0 = gn0[c2], g1 = gn1[c2];
                const u32x4 uu = uus[jb][c2];
                const f32x4 s0 = acc[jb][c2][0] * g0 + bs, s1 = acc[jb][c2][1] * g1 + bs;
                const f32x2 ua = pg8::gelu_pk((f32x2){bf_lo(uu.x), bf_hi(uu.x)}), ub = pg8::gelu_pk((f32x2){bf_lo(uu.y), bf_hi(uu.y)}), uc = pg8::gelu_pk((f32x2){bf_lo(uu.z), bf_hi(uu.z)}), ud = pg8::gelu_pk((f32x2){bf_lo(uu.w), bf_hi(uu.w)});
                u32x4 w; w.x = cvt_pk_bf16(ua.x * s0[0], ua.y * s0[1]); w.y = cvt_pk_bf16(ub.x * s0[2], ub.y * s0[3]);
                w.z = cvt_pk_bf16(uc.x * s1[0], uc.y * s1[1]); w.w = cvt_pk_bf16(ud.x * s1[2], ud.y * s1[3]);
                *(u32x4*)(tb + (size_t)(r0 + p) * 2048 + col) = w; } }
        __syncthreads();
    }
#undef SG_LOADV
}

template <int LAYER> __device__ __forceinline__ void route_phase(const Params& P, const Ctx& F) {
    constexpr int NROWS = LAYER == 0 ? T : TL, NT = NROWS / 32;
    const bf16_t* X = (const bf16_t*)(P.ws + (LAYER == 0 ? WS_X1 : WS_X3C));
    const float* mod = (const float*)(P.ws + WS_MOD) + (size_t)LAYER * 9 * 6144;
    const bf16_t* rwh = (const bf16_t*)(P.ws + WS_RWH) + (size_t)LAYER * 32 * 1024; const bf16_t* rwl = (const bf16_t*)(P.ws + WS_RWL) + (size_t)LAYER * 32 * 1024;
    unsigned char* fb = P.ws + WS_FBUF;
    int* cnt = (int*)(P.ws + WS_CNT + LAYER * 8192); int* list = (int*)(P.ws + WS_LIST) + (size_t)LAYER * NE * ECAP;
    int* te = (int*)(P.ws + WS_TE) + (size_t)LAYER * T * 4; int* tp = (int*)(P.ws + WS_TP) + (size_t)LAYER * T * 4; float* tg = (float*)(P.ws + WS_TG) + (size_t)LAYER * T * 4;
    const int i = F.lane & 31, h = F.lane >> 5, w = F.wave;
    LAS unsigned char* XS = F.lds + w * 8704;
    LAS unsigned char* FS = F.lds + 69632 + w * 4608;
    LAS float* part = (LAS float*)XS;
    LAS float* ssum = (LAS float*)(F.lds + 106496);
    LAS float* logit = (LAS float*)(F.lds + 107520);
    LAS int* lcnt = (LAS int*)(F.lds + 111744);
    LAS int* gbase = lcnt + 32;
    LAS int* rec_e = (LAS int*)(F.lds + 112128);
    LAS int* rec_l = rec_e + 512; LAS float* rec_g = (LAS float*)(rec_l + 512);
    LAS float* avec = (LAS float*)(F.lds + 118784);
    LAS float* svec = avec + 1024;
    if (F.tid < 32) lcnt[F.tid] = 0;
    const float rbias = P.router_b[LAYER * 32 + (F.tid & 31)];
    bf16x8 bh[8], bl[8];
#pragma unroll
    for (int ks = 0; ks < 8; ++ks) { bh[ks] = *(const bf16x8*)(rwh + (size_t)i * 1024 + 128 * w + 16 * ks + 8 * h); bl[ks] = *(const bf16x8*)(rwl + (size_t)i * 1024 + 128 * w + 16 * ks + 8 * h); }
    const int lc = F.lane & 15, lr = F.lane >> 4;
    u32x4 raw[8];
    int tile = F.bid, ti = 0;
    if (tile < NT) {
#pragma unroll
        for (int j = 0; j < 8; ++j) raw[j] = *(const u32x4*)(X + (size_t)(tile * 32 + 4 * j + lr) * 1024 + 128 * w + 8 * lc); }
    for (; tile < NT; tile += F.G, ++ti) {
        const int row = tile * 32 + i;
        const int mr = LAYER == 0 ? mod_row(tile * 32) : (tile * 32) / LSEQ;
        const float* md = mod + (size_t)mr * 6144;
#pragma unroll
        for (int j = 0; j < 8; ++j) *(LAS u32x4*)(XS + (4 * j + lr) * 272 + 16 * lc) = raw[j];
        const int k2 = 2 * F.tid; const f32x2 mg = *(const f32x2*)(P.norm_ffn + LAYER * 1024 + k2), msc = *(const f32x2*)(md + 4096 + k2), msh = *(const f32x2*)(md + 3072 + k2);
        if (tile + F.G < NT) {
#pragma unroll
            for (int j = 0; j < 8; ++j) raw[j] = *(const u32x4*)(X + (size_t)((tile + F.G) * 32 + 4 * j + lr) * 1024 + 128 * w + 8 * lc); }
        asm volatile("s_waitcnt lgkmcnt(0)" ::: "memory");
        const LAS unsigned char* xfr = XS + i * 272 + 16 * h;
        float ss = 0.f;
#pragma unroll
        for (int ks = 0; ks < 8; ++ks) { const u32x4 xw = *(const LAS u32x4*)(xfr + 32 * ks);
            const float a0 = bf_lo(xw.x), a1 = bf_hi(xw.x), a2 = bf_lo(xw.y), a3 = bf_hi(xw.y), a4 = bf_lo(xw.z), a5 = bf_hi(xw.z), a6 = bf_lo(xw.w), a7 = bf_hi(xw.w);
            ss += ((a0 * a0 + a1 * a1) + (a2 * a2 + a3 * a3)) + ((a4 * a4 + a5 * a5) + (a6 * a6 + a7 * a7)); }
        ss += __shfl_xor(ss, 32);
        if (h == 0) ssum[w * 32 + i] = ss;
        *(LAS f32x2*)(avec + k2) = mg * (msc + 1.0f); *(LAS f32x2*)(svec + k2) = msh;
        __syncthreads();
        float tot = 0.f;
#pragma unroll
        for (int j = 0; j < 8; ++j) tot += ssum[j * 32 + i];
        const float rstd = rsqrtf(tot * (1.0f / 1024.0f) + NORM_EPS);
        f32x16 acc = {};
#pragma unroll
        for (int ks = 0; ks < 8; ++ks) {
            const int k = 128 * w + 16 * ks + 8 * h;
            const u32x4 xw = *(const LAS u32x4*)(xfr + 32 * ks);
            const f32x4 xa = (f32x4){bf_lo(xw.x), bf_hi(xw.x), bf_lo(xw.y), bf_hi(xw.y)}, xb = (f32x4){bf_lo(xw.z), bf_hi(xw.z), bf_lo(xw.w), bf_hi(xw.w)};
            const f32x4 aa = *(const LAS f32x4*)(avec + k), ab = *(const LAS f32x4*)(avec + k + 4), sha = *(const LAS f32x4*)(svec + k), shb = *(const LAS f32x4*)(svec + k + 4);
            const f32x4 fa = (xa * rstd) * aa + sha, fb4 = (xb * rstd) * ab + shb;
            u32x4 hw; hw.x = cvt_pk_bf16(fa[0], fa[1]); hw.y = cvt_pk_bf16(fa[2], fa[3]); hw.z = cvt_pk_bf16(fb4[0], fb4[1]); hw.w = cvt_pk_bf16(fb4[2], fb4[3]);
            u32x4 lw; lw.x = cvt_pk_bf16(fa[0] - bf_lo(hw.x), fa[1] - bf_hi(hw.x)); lw.y = cvt_pk_bf16(fa[2] - bf_lo(hw.y), fa[3] - bf_hi(hw.y));
            lw.z = cvt_pk_bf16(fb4[0] - bf_lo(hw.z), fb4[1] - bf_hi(hw.z)); lw.w = cvt_pk_bf16(fb4[2] - bf_lo(hw.w), fb4[3] - bf_hi(hw.w));
            { const f32x4 qa = fa * F8_SX, qb = fb4 * F8_SX; u32x2 q8; q8.x = pk_fp8x4(qa[0], qa[1], qa[2], qa[3]); q8.y = pk_fp8x4(qb[0], qb[1], qb[2], qb[3]); *(LAS u32x2*)(FS + i * 144 + 16 * ks + 8 * h) = q8; }
            const bf16x8 ah = *reinterpret_cast<bf16x8*>(&hw), alo = *reinterpret_cast<bf16x8*>(&lw);
            acc = __builtin_amdgcn_mfma_f32_32x32x16_bf16(ah, bh[ks], acc, 0, 0, 0);
            acc = __builtin_amdgcn_mfma_f32_32x32x16_bf16(ah, bl[ks], acc, 0, 0, 0);
            acc = __builtin_amdgcn_mfma_f32_32x32x16_bf16(alo, bh[ks], acc, 0, 0, 0);
        }
        asm volatile("s_waitcnt lgkmcnt(0)" ::: "memory");
#pragma unroll
        for (int t = 0; t < 4; ++t) { const int q = F.lane + 64 * t, fr_ = q >> 3, ch = q & 7;
            *(u32x4*)(fb + (size_t)(tile * 32 + fr_) * 1024 + 128 * w + 16 * ch) = *(const LAS u32x4*)(FS + fr_ * 144 + 16 * ch); }
#pragma unroll
        for (int r = 0; r < 16; ++r) { const int tok = (r & 3) + 8 * (r >> 2) + 4 * h; part[tok * 33 + i] = acc[r]; }
        __syncthreads();
#pragma unroll
        for (int q = 0; q < 2; ++q) { const int idx = F.tid + 512 * q, tok = idx >> 5, e = idx & 31; float sacc = 0.f;
#pragma unroll
            for (int j = 0; j < 8; ++j) sacc += ((const LAS float*)(F.lds + j * 8704))[tok * 33 + e];
            logit[tok * 33 + e] = sacc + rbias; }
        __syncthreads();
#pragma unroll
        for (int pass = 0; pass < 2; ++pass) {
            const int tok = 4 * w + 2 * pass + h;
            float v = logit[tok * 33 + i]; float bv[4]; int bi[4];
#pragma unroll
            for (int rnd = 0; rnd < 4; ++rnd) {
                float cv = v; int ci = i;
#pragma unroll
                for (int off = 16; off >= 1; off >>= 1) { const float ov = __shfl_xor(cv, off); const int oi = __shfl_xor(ci, off); const bool take = (ov > cv) || (ov == cv && oi < ci); cv = take ? ov : cv; ci = take ? oi : ci; }
                bv[rnd] = cv; bi[rnd] = ci; if (i == ci) v = -3.0e38f;
            }
            if (i == 0) {
                const int l0 = atomicAdd((int*)(lcnt + bi[0]), 1), l1 = atomicAdd((int*)(lcnt + bi[1]), 1), l2 = atomicAdd((int*)(lcnt + bi[2]), 1), l3 = atomicAdd((int*)(lcnt + bi[3]), 1);
                const float e1 = __expf(bv[1] - bv[0]), e2 = __expf(bv[2] - bv[0]), e3 = __expf(bv[3] - bv[0]), inv = 1.0f / (1.0f + e1 + e2 + e3);
                const int o = (ti * 32 + tok) * 4;
                rec_e[o] = bi[0]; rec_e[o + 1] = bi[1]; rec_e[o + 2] = bi[2]; rec_e[o + 3] = bi[3]; rec_l[o] = l0; rec_l[o + 1] = l1; rec_l[o + 2] = l2; rec_l[o + 3] = l3;
                rec_g[o] = inv; rec_g[o + 1] = e1 * inv; rec_g[o + 2] = e2 * inv; rec_g[o + 3] = e3 * inv;
            }
        }
        __syncthreads();
    }
    __syncthreads();
    if (F.tid < 32) { const int c = lcnt[F.tid]; gbase[F.tid] = c ? __hip_atomic_fetch_add(cnt + F.tid * 64, c, __ATOMIC_RELAXED, __HIP_MEMORY_SCOPE_AGENT) : 0; }
    __syncthreads();
    if (F.tid < ti * 32) {
        const int tl = F.tid >> 5, r = (F.bid + tl * F.G) * 32 + (F.tid & 31), o = F.tid * 4;
        const int i0 = rec_e[o], i1 = rec_e[o + 1], i2 = rec_e[o + 2], i3 = rec_e[o + 3];
        const int p0 = gbase[i0] + rec_l[o], p1 = gbase[i1] + rec_l[o + 1], p2 = gbase[i2] + rec_l[o + 2], p3 = gbase[i3] + rec_l[o + 3];
        list[(size_t)i0 * ECAP + p0] = r; list[(size_t)i1 * ECAP + p1] = r; list[(size_t)i2 * ECAP + p2] = r; list[(size_t)i3 * ECAP + p3] = r;
        *(int4*)(te + (size_t)r * 4) = make_int4(i0, i1, i2, i3); *(int4*)(tp + (size_t)r * 4) = make_int4(p0, p1, p2, p3);
        *(float4*)(tg + (size_t)r * 4) = make_float4(rec_g[o], rec_g[o + 1], rec_g[o + 2], rec_g[o + 3]);
    }
    __syncthreads();
}

__device__ __forceinline__ void moe_prefix(const Params& P, const Ctx& F, int layer, LAS int* tbl) {
    const int* cnt = (const int*)(P.ws + WS_CNT + layer * 8192);
    __syncthreads();
    if (F.tid < 32) tbl[33 + F.tid] = ld_agent(cnt + F.tid * 64);
    __syncthreads();
    if (F.tid == 0) { int a = 0; for (int e = 0; e < 32; ++e) { tbl[e] = a; tbl[66 + e] = a >> 8; a += (tbl[33 + e] + 255) & ~255; } tbl[32] = a; tbl[98] = a >> 8; }
    __syncthreads();
}

__device__ __forceinline__ void acc_y16(float (&y)[16], const u32x4 w, float gs) {
#pragma unroll
    for (int q = 0; q < 4; ++q) { const f32x2 lo = __builtin_amdgcn_cvt_pk_f32_fp8((int)w[q], false), hi = __builtin_amdgcn_cvt_pk_f32_fp8((int)w[q], true);
        y[4 * q + 0] = fmaf(lo.x, gs, y[4 * q + 0]); y[4 * q + 1] = fmaf(lo.y, gs, y[4 * q + 1]); y[4 * q + 2] = fmaf(hi.x, gs, y[4 * q + 2]); y[4 * q + 3] = fmaf(hi.y, gs, y[4 * q + 3]); }
}
template <int LAYER> __device__ __forceinline__ void combine_phase(const Params& P, const Ctx& F, LAS int* tbl) {
    constexpr int NR = LAYER == 0 ? T : TL;
    const float* mod = (const float*)(P.ws + WS_MOD); const bf16_t* xin = (const bf16_t*)(P.ws + (LAYER == 0 ? WS_X1 : WS_X3C)); const unsigned char* yb = P.ws + WS_YB;
    const int* te = (const int*)(P.ws + WS_TE) + (size_t)LAYER * T * 4; const int* tp = (const int*)(P.ws + WS_TP) + (size_t)LAYER * T * 4; const float* tg = (const float*)(P.ws + WS_TG) + (size_t)LAYER * T * 4;
    bf16_t* x2c = (bf16_t*)(P.ws + WS_X2C); unsigned char* hb = P.ws + WS_HBUF;
    const int nwaves = F.G * 8, rpw = (NR + nwaves - 1) / nwaves, col = 16 * F.lane;
    const int rbeg = (F.bid * 8 + F.wave) * rpw, rend = (rbeg + rpw < NR) ? rbeg + rpw : NR;
    if (rbeg >= rend) return;
    f32x4 g2v[4], nmv[4], scv[4], shv[4]; int cur_mr = -1;
    int my[2], myp[2]; float myg[2]; u32x4 xw[2][2];
#define CB_META(R0) do { _Pragma("unroll") for (int q = 0; q < 2; ++q) { const int r_ = ((R0) + q < rend) ? (R0) + q : (R0); \
        my[q] = (F.lane < 4) ? te[(size_t)r_ * 4 + F.lane] : 0; myp[q] = (F.lane < 4) ? tp[(size_t)r_ * 4 + F.lane] : 0; myg[q] = (F.lane < 4) ? tg[(size_t)r_ * 4 + F.lane] : 0.f; \
        _Pragma("unroll") for (int j = 0; j < 2; ++j) xw[q][j] = *(const u32x4*)(xin + (size_t)r_ * 1024 + col + 8 * j); } } while (0)
    CB_META(rbeg);
    for (int r0 = rbeg; r0 < rend; r0 += 2) {
        const bool ok1 = r0 + 1 < rend;
        u32x4 w[2][4]; float gk[2][4]; u32x4 xc[2][2];
#pragma unroll
        for (int q = 0; q < 2; ++q) {
#pragma unroll
            for (int k = 0; k < 4; ++k) { const int e = __shfl(my[q], k), pos = __shfl(myp[q], k); gk[q][k] = __shfl(myg[q], k) * (1.0f / F8_SY); w[q][k] = *(const u32x4*)(yb + (size_t)(tbl[e] + pos) * 1024 + col); }
            xc[q][0] = xw[q][0]; xc[q][1] = xw[q][1]; }
        if (r0 + 2 < rend) CB_META(r0 + 2);
#pragma unroll
        for (int q = 0; q < 2; ++q) {
            if (q == 1 && !ok1) break;
            const int r = r0 + q;
            int mr; int b = 0, p = 0;
            if (LAYER == 0) { b = r / TBR; p = r - b * TBR; mr = p < CTXL ? 8 : b; } else mr = r / LSEQ;
            if (mr != cur_mr) { cur_mr = mr;
                const float* md0 = mod + (size_t)(LAYER * 9 + mr) * 6144; const float* md1 = mod + (size_t)(9 + mr) * 6144;
#pragma unroll
                for (int j = 0; j < 4; ++j) { g2v[j] = *(const f32x4*)(md0 + 5120 + col + 4 * j);
                    if (LAYER == 0) { nmv[j] = *(const f32x4*)(P.norm_mix + 1024 + col + 4 * j); scv[j] = *(const f32x4*)(md1 + 1024 + col + 4 * j) + 1.0f; shv[j] = *(const f32x4*)(md1 + col + 4 * j); } } }
            float y[16];
#pragma unroll
            for (int j = 0; j < 16; ++j) y[j] = 0.f;
#pragma unroll
            for (int k = 0; k < 4; ++k) acc_y16(y, w[q][k], gk[q][k]);
            f32x4 xv[4];
#pragma unroll
            for (int j = 0; j < 2; ++j) { const u32x4 t = xc[q][j]; xv[2 * j] = (f32x4){bf_lo(t.x), bf_hi(t.x), bf_lo(t.y), bf_hi(t.y)}; xv[2 * j + 1] = (f32x4){bf_lo(t.z), bf_hi(t.z), bf_lo(t.w), bf_hi(t.w)}; }
            if (LAYER == 0) {
                f32x4 v[4]; float ss = 0.f;
#pragma unroll
                for (int j = 0; j < 4; ++j) { v[j] = xv[j] + g2v[j] * (f32x4){y[4 * j], y[4 * j + 1], y[4 * j + 2], y[4 * j + 3]}; ss += (v[j][0] * v[j][0] + v[j][1] * v[j][1]) + (v[j][2] * v[j][2] + v[j][3] * v[j][3]); }
                if (p >= CTXL) {
#pragma unroll
                    for (int j = 0; j < 2; ++j) { u32x4 o; o.x = cvt_pk_bf16(v[2 * j][0], v[2 * j][1]); o.y = cvt_pk_bf16(v[2 * j][2], v[2 * j][3]); o.z = cvt_pk_bf16(v[2 * j + 1][0], v[2 * j + 1][1]); o.w = cvt_pk_bf16(v[2 * j + 1][2], v[2 * j + 1][3]);
                        *(u32x4*)(x2c + ((size_t)b * LSEQ + p - CTXL) * 1024 + col + 8 * j) = o; } }
                ss = wave_sum(ss); const float rstd = rsqrtf(ss * (1.0f / 1024.0f) + NORM_EPS) * F8_SX;
                u32x4 o;
#pragma unroll
                for (int j = 0; j < 4; ++j) { const f32x4 hh = (v[j] * rstd) * nmv[j] * scv[j] + shv[j] * F8_SX; o[j] = pk_fp8x4(hh[0], hh[1], hh[2], hh[3]); }
                *(u32x4*)(hb + (size_t)r * 1024 + col) = o;
            } else {
#pragma unroll
                for (int j = 0; j < 4; ++j) *(f32x4*)(P.out + (size_t)r * 1024 + col + 4 * j) = xv[j] + g2v[j] * (f32x4){y[4 * j], y[4 * j + 1], y[4 * j + 2], y[4 * j + 3]};
            }
        }
    }
#undef CB_META
}

constexpr int NPH = 16;
__global__ void __launch_bounds__(NTHREADS, 2) mk_fwd(Params P) {
    extern __shared__ __attribute__((aligned(16))) unsigned char lds_raw[];
    Ctx F; F.lds = (LAS unsigned char*)lds_raw; F.tid = threadIdx.x; F.lane = F.tid & 63; F.wave = __builtin_amdgcn_readfirstlane(F.tid >> 6); F.G = gridDim.x; F.bid = blockIdx.x;
    LAS unsigned* misc = (LAS unsigned*)(F.lds + MISC_OFF);
    LAS int* tbl = (LAS int*)(F.lds + MISC_OFF + 64);
    if (F.tid < 4) misc[F.tid] = 0u;
    __syncthreads();
    const int lo = P.ph_lo, hi = P.ph_hi;
    XcdBarrier bar; bar.bar = (unsigned*)(P.ws + WS_BAR); bar.x = 0; bar.st = (volatile LAS unsigned*)misc;
    if (hi - lo > 1) bar = xcd_barrier_post((unsigned*)(P.ws + WS_BAR), (volatile LAS unsigned*)misc);
#define IN(k) (lo <= (k) && (k) < hi)
#define SEAM(k) do { if (IN(k) && IN((k) + 1)) xcd_barrier(bar); } while (0)
    unsigned char* ws = P.ws;
    const float* mod = (const float*)(ws + WS_MOD);

    LAS int* rlbuf = (LAS int*)(F.lds + RL_OFF);
    if (IN(0)) { ada_phase(P, F); cvt_phase(P, F); } SEAM(0);
    if (IN(1)) { norm0_phase(P, F); } SEAM(1);
    if (IN(2)) {
        pg8::StaticOrder S; S.init(ws + WS_HBUF, ws + WS_WIN, T, 4096, 1024, F.G, F.bid);
        pg8::EpiGeluV E{(bf16_t*)(ws + WS_UV), P.gm_b_in, (float*)(ws + WS_VSS)};
        pg8::gemm_phase<false, 0, 0, false>(F.lds, rlbuf, 1024, (size_t)128 * 1024 * 2, S, E);
        tail_fill(P, F, 0, 2, (T / 256) * 16);
    } SEAM(2);
    if (IN(3)) { sgate_phase(P, F); } SEAM(3);
    if (IN(4)) {
        pg8::StaticOrder S; S.init(ws + WS_TBUF, ws + WS_WOUT, T, 1024, 2048, F.G, F.bid);
        pg8::EpiResid<0> E{P.x, P.ctx, nullptr, mod, (bf16_t*)(ws + WS_X1)};
        pg8::gemm_phase<false, 0, 0, false>(F.lds, rlbuf, 2048, (size_t)128 * 2048 * 2, S, E);
        tail_fill(P, F, 0, 4, (T / 256) * 4);
    } SEAM(4);
    if (IN(5)) { route_phase<0>(P, F); cvt_fill(P, F, 0, nullptr, -1); } SEAM(5);
    if (IN(6)) {
        moe_prefix(P, F, 0, tbl);
        MoeOrder S{(const char*)(ws + WS_FBUF), (const char*)(ws + WS_WGU), tbl + 66, tbl + 33, (const int*)(ws + WS_LIST), tbl[98], 8, F.G, F.bid, (size_t)256 * 1024, (size_t)2048 * 1024, (size_t)128 * 1024};
        pg8::EpiSwiglu E{ws + WS_ACT, P.b_gu};
        pg8::gemm_phase<true, F8_EW, F8_EX, true>(F.lds, rlbuf, 512, (size_t)1024 * 1024, S, E);
        tail_fill(P, F, 1, 6, tbl[98] * 8);
    } SEAM(6);
    if (IN(7)) {
        moe_prefix(P, F, 0, tbl);
        MoeOrder S{(const char*)(ws + WS_ACT), (const char*)(ws + WS_WDN), tbl + 66, tbl + 33, nullptr, tbl[98], 4, F.G, F.bid, (size_t)256 * 1024, (size_t)1024 * 1024, (size_t)256 * 1024};
        pg8::EpiFp8 E{ws + WS_YB, P.b_dn};
        pg8::gemm_phase<true, F8_EW, F8_EA, false>(F.lds, rlbuf, 512, (size_t)0, S, E);
        tail_fill(P, F, 1, 7, tbl[98] * 4);
    } SEAM(7);
    if (IN(8)) { moe_prefix(P, F, 0, tbl); combine_phase<0>(P, F, tbl); } SEAM(8);
    if (IN(9)) {
        pg8::QkvOrder S{(const char*)(ws + WS_HBUF), (const char*)(ws + WS_WQKV), F.G, F.bid, (size_t)256 * 1024};
        pg8::EpiQKV E{(bf16_t*)(ws + WS_QB), (bf16_t*)(ws + WS_KB), (bf16_t*)(ws + WS_VB), P.at_q_gain, P.at_k_gain, (LAS float*)(F.lds + QKP_OFF)};
        pg8::gemm_phase<true, F8_EW, F8_EX, false>(F.lds, rlbuf, 512, (size_t)128 * 1024, S, E);
        tail_fill(P, F, 1, 9, 400);
    } SEAM(9);
    if (IN(10)) {
        const unsigned char* Qb = ws + WS_QB; const unsigned char* Kb = ws + WS_KB; const unsigned char* Vb = ws + WS_VB; bf16_t* Ob = (bf16_t*)(ws + WS_OB);
        for (int u = F.bid; u < NB * 8 * 8; u += F.G) {
            const int b = u >> 6, h = (u >> 3) & 7, qb = u & 7;
            const size_t qo = (((size_t)b * 8 + h) * LSEQ + qb * 256) * 128, ko = ((size_t)b * 2 + (h >> 2)) * TBR * 128, oo = ((size_t)b * LSEQ + qb * 256) * 1024 + h * 128;
            att::attn_dense_body(Qb + qo, Kb + ko, Vb + ko, Ob + oo, TBR, (char*)lds_raw);
        }
    } SEAM(10);
    if (IN(11)) {
        pg8::StaticOrder S; S.init(ws + WS_OB, ws + WS_WO, TL, 1024, 1024, F.G, F.bid);
        pg8::EpiResid<1> E{nullptr, nullptr, (const bf16_t*)(ws + WS_X2C), mod, (bf16_t*)(ws + WS_X3C)};
        pg8::gemm_phase<false, 0, 0, false>(F.lds, rlbuf, 1024, (size_t)128 * 1024 * 2, S, E);
    } SEAM(11);
    if (IN(12)) { route_phase<1>(P, F); cvt_fill(P, F, 1, nullptr, -1); } SEAM(12);
    if (IN(13)) {
        moe_prefix(P, F, 1, tbl);
        MoeOrder S{(const char*)(ws + WS_FBUF), (const char*)(ws + WS_WGU) + (size_t)32 * 2048 * 1024, tbl + 66, tbl + 33, (const int*)(ws + WS_LIST) + (size_t)NE * ECAP, tbl[98], 8, F.G, F.bid, (size_t)256 * 1024, (size_t)2048 * 1024, (size_t)128 * 1024};
        pg8::EpiSwiglu E{ws + WS_ACT, P.b_gu + (size_t)32 * 2048};
        pg8::gemm_phase<true, F8_EW, F8_EX, true>(F.lds, rlbuf, 512, (size_t)1024 * 1024, S, E);
    } SEAM(13);
    if (IN(14)) {
        moe_prefix(P, F, 1, tbl);
        MoeOrder S{(const char*)(ws + WS_ACT), (const char*)(ws + WS_WDN) + (size_t)32 * 1024 * 1024, tbl + 66, tbl + 33, nullptr, tbl[98], 4, F.G, F.bid, (size_t)256 * 1024, (size_t)1024 * 1024, (size_t)256 * 1024};
        pg8::EpiFp8 E{ws + WS_YB, P.b_dn + (size_t)32 * 1024};
        pg8::gemm_phase<true, F8_EW, F8_EA, false>(F.lds, rlbuf, 512, (size_t)0, S, E);
    } SEAM(14);
    if (IN(15)) { moe_prefix(P, F, 1, tbl); combine_phase<1>(P, F, tbl); }
#undef IN
#undef SEAM
}

extern "C" void kernel_launch(void* const* d_in, const int* in_sizes, int n_in, void* d_out, int out_size, void* d_ws, size_t ws_size, hipStream_t stream) {
    static int grid = 0;
    if (grid == 0) {
        if (n_in != 24 || in_sizes[0] != NB * LSEQ * DM || out_size != NB * LSEQ * DM || ws_size < WS_END) {
            fprintf(stderr, "kernel_launch: shape / workspace mismatch (n_in %d, in0 %d, out %d, ws %zu, need %zu); nothing launched\n", n_in, n_in > 0 ? in_sizes[0] : -1, out_size, ws_size, (size_t)WS_END); grid = -1; return; }
        int dev = 0, cus = 0, per_cu = 0;
        if (hipGetDevice(&dev) != hipSuccess || hipDeviceGetAttribute(&cus, hipDeviceAttributeMultiprocessorCount, dev) != hipSuccess) { grid = -1; return; }
        if (hipFuncSetAttribute((const void*)mk_fwd, hipFuncAttributeMaxDynamicSharedMemorySize, LDS_BYTES) != hipSuccess) { fprintf(stderr, "kernel_launch: hipFuncSetAttribute failed\n"); grid = -1; return; }
        if (hipOccupancyMaxActiveBlocksPerMultiprocessor(&per_cu, (const void*)mk_fwd, NTHREADS, LDS_BYTES) != hipSuccess || per_cu < 1) { fprintf(stderr, "kernel_launch: occupancy query reports %d\n", per_cu); (void)hipGetLastError(); }
        grid = cus;
    }
    if (grid < 0) return;
    if (hipMemsetAsync((char*)d_ws, 0, WS_ZERO_BYTES, stream) != hipSuccess) return;
    Params p{};
    const float** pf = (const float**)&p;
    for (int i = 0; i < 24; ++i) pf[i] = (const float*)d_in[i];
    p.out = (float*)d_out; p.ws = (unsigned char*)d_ws;
#if MK_N_LAUNCHES == 1
    p.ph_lo = 0; p.ph_hi = NPH;
    hipLaunchKernelGGL(mk_fwd, dim3(grid), dim3(NTHREADS), LDS_BYTES, stream, p);
#else
    for (int ph = 0; ph < NPH; ++ph) { p.ph_lo = ph; p.ph_hi = ph + 1; hipLaunchKernelGGL(mk_fwd, dim3(grid), dim3(NTHREADS), LDS_BYTES, stream, p);
        if ((MK_REPEAT_MASK >> ph) & 1u) hipLaunchKernelGGL(mk_fwd, dim3(grid), dim3(NTHREADS), LDS_BYTES, stream, p); }
#endif
    const hipError_t le = hipPeekAtLastError();
    if (le != hipSuccess) fprintf(stderr, "kernel_launch: launch failed: %s\n", hipGetErrorName(le));
}
```

```cpp
#include <hip/hip_runtime.h>
#include <cstdio>
#include <cstdint>

#ifndef MK_REPEAT_MASK
#define MK_REPEAT_MASK 0u
#endif
#ifndef MOE_CONV_WGS
#define MOE_CONV_WGS 32
#endif
#ifndef MK_N_LAUNCHES
#define MK_N_LAUNCHES 1
#endif

#define LAS __attribute__((address_space(3)))
typedef unsigned short bf16_t;
typedef short bf16x8 __attribute__((ext_vector_type(8)));
typedef short s16x4 __attribute__((ext_vector_type(4)));
typedef float f32x2 __attribute__((ext_vector_type(2)));
typedef float f32x4 __attribute__((ext_vector_type(4)));
typedef float f32x16 __attribute__((ext_vector_type(16)));
typedef unsigned u32x2 __attribute__((ext_vector_type(2)));
typedef unsigned u32x4 __attribute__((ext_vector_type(4)));
typedef int i32x4 __attribute__((ext_vector_type(4)));
typedef int i32x8 __attribute__((ext_vector_type(8)));

constexpr int NB = 8, LSEQ = 2048, CTXL = 256, DM = 1024, TBR = LSEQ + CTXL, T = NB * TBR, TL = NB * LSEQ;
constexpr int NE = 32, TOPK = 4, ECAP = T;
constexpr int SLOTS_MAX = T * TOPK + NE * 256;
constexpr int GMW = 2048, QKVW = 1536, HD = 128;
constexpr float NORM_EPS = 1e-6f;
constexpr int NTHREADS = 512;

constexpr size_t al256(size_t x) { return (x + 255) & ~(size_t)255; }
constexpr size_t WS_BAR   = 0;
constexpr size_t WS_CNT   = 16384;
constexpr size_t WS_QHEAD = 32768;
constexpr size_t WS_PHDONE = 32768 + 1024;
constexpr size_t WS_ZERO_BYTES = 65536;
constexpr size_t WS_MOD   = WS_ZERO_BYTES;
constexpr size_t WS_RWH   = WS_MOD + al256((size_t)2 * 9 * 6144 * 4);
constexpr size_t WS_RWL   = WS_RWH + (size_t)2 * 32 * 1024 * 2;
constexpr size_t WS_WIN   = WS_RWL + (size_t)2 * 32 * 1024 * 2;
constexpr size_t WS_WOUT  = WS_WIN + (size_t)4096 * 1024 * 2;
constexpr size_t WS_WQKV  = WS_WOUT + (size_t)1024 * 2048 * 2;
constexpr size_t WS_WO    = WS_WQKV + (size_t)1536 * 1024 * 2;
constexpr size_t WS_WGU   = WS_WO + (size_t)1024 * 1024 * 2;
constexpr size_t WS_WDN   = WS_WGU + (size_t)64 * 2048 * 1024 * 2;
constexpr size_t WS_HBUF  = WS_WDN + (size_t)64 * 1024 * 1024 * 2;
constexpr size_t WS_UV    = WS_HBUF + (size_t)T * 1024 * 2;
constexpr size_t WS_VSS   = WS_UV + (size_t)T * 4096 * 2;
constexpr size_t WS_TBUF  = WS_VSS + (size_t)T * 32 * 4;
constexpr size_t WS_X1    = WS_TBUF + (size_t)T * 2048 * 2;
constexpr size_t WS_FBUF  = WS_X1 + (size_t)T * 1024 * 4;
constexpr size_t WS_TE    = WS_FBUF + (size_t)T * 1024 * 2;
constexpr size_t WS_TP    = WS_TE + (size_t)2 * T * 4 * 4;
constexpr size_t WS_TG    = WS_TP + (size_t)2 * T * 4 * 4;
constexpr size_t WS_LIST  = WS_TG + (size_t)2 * T * 4 * 4;
constexpr size_t WS_XG    = WS_LIST + (size_t)2 * NE * ECAP * 4;
constexpr size_t WS_ACT   = WS_XG + (size_t)SLOTS_MAX * 1024 * 2;
constexpr size_t WS_YB    = WS_ACT + (size_t)SLOTS_MAX * 1024 * 2;
constexpr size_t WS_X2C   = WS_YB + (size_t)SLOTS_MAX * 1024 * 2;
constexpr size_t WS_QKV   = WS_X2C + (size_t)TL * 1024 * 4;
constexpr size_t WS_QB    = WS_QKV + (size_t)T * 1536 * 2;
constexpr size_t WS_KB    = WS_QB + (size_t)TL * 1024 * 2;
constexpr size_t WS_VB    = WS_KB + (size_t)T * 256 * 2;
constexpr size_t WS_OB    = WS_VB + (size_t)T * 256 * 2;
constexpr size_t WS_X3C   = WS_OB + (size_t)TL * 1024 * 2;
constexpr size_t WS_END   = WS_X3C + (size_t)TL * 1024 * 4;

constexpr int RING_BYTES = 131072, MISC_OFF = RING_BYTES, RL_OFF = MISC_OFF + 512, QKP_OFF = RL_OFF + 2048, LDS_BYTES = RING_BYTES + 512 + 2048 + 8192;

struct Params {
    const float *x, *c, *ctx, *c_ctx, *ada_w, *ada_b, *norm_mix, *norm_ffn, *gm_w_in, *gm_b_in, *gm_v_gain, *gm_w_s, *gm_b_s, *gm_w_out,
                *at_w_qkv, *at_q_gain, *at_k_gain, *at_w_o, *router_w, *router_b, *w_gu, *b_gu, *w_dn, *b_dn;
    float* out; unsigned char* ws; int ph_lo, ph_hi;
};

__device__ __forceinline__ unsigned cvt_pk_bf16(float lo, float hi) { unsigned r; asm volatile("v_cvt_pk_bf16_f32 %0, %1, %2" : "=v"(r) : "v"(lo), "v"(hi)); return r; }
__device__ __forceinline__ unsigned pk_fp8x4(float a, float b, float c, float d) {
    a = __builtin_amdgcn_fmed3f(a, -448.f, 448.f); b = __builtin_amdgcn_fmed3f(b, -448.f, 448.f); c = __builtin_amdgcn_fmed3f(c, -448.f, 448.f); d = __builtin_amdgcn_fmed3f(d, -448.f, 448.f);
    int w = __builtin_amdgcn_cvt_pk_fp8_f32(a, b, 0, false); w = __builtin_amdgcn_cvt_pk_fp8_f32(c, d, w, true); return (unsigned)w;
}
__device__ __forceinline__ unsigned pk_fp8x4_nc(float a, float b, float c, float d) {
    int w = __builtin_amdgcn_cvt_pk_fp8_f32(a, b, 0, false); w = __builtin_amdgcn_cvt_pk_fp8_f32(c, d, w, true); return (unsigned)w;
}
constexpr float F8_SX = 32.f, F8_SW = 256.f, F8_SA = 4.f, F8_SY = 64.f;
constexpr int F8_EX = 0x7a7a7a7a, F8_EW = 0x77777777, F8_EA = 0x7d7d7d7d;
__device__ __forceinline__ float bf_lo(unsigned w) { return __uint_as_float(w << 16); }
__device__ __forceinline__ float bf_hi(unsigned w) { return __uint_as_float(w & 0xffff0000u); }
__device__ __forceinline__ float wave_sum(float v) {
#pragma unroll
    for (int o = 32; o >= 1; o >>= 1) v += __shfl_xor(v, o);
    return v;
}
__device__ __forceinline__ int ld_agent(const int* p) { return __hip_atomic_load(p, __ATOMIC_RELAXED, __HIP_MEMORY_SCOPE_AGENT); }
__device__ __forceinline__ int mod_row(int r) { const int b = r / TBR, p = r - b * TBR; return p < CTXL ? 8 : b; }
__device__ __forceinline__ const float* src_row(const Params& P, int r) {
    const int b = r / TBR, p = r - b * TBR;
    return p < CTXL ? P.ctx + (size_t)(b * CTXL + p) * DM : P.x + (size_t)(b * LSEQ + p - CTXL) * DM;
}

#define XB_TMO      128
#define XB_XCNT(j)  (256  + 64 * (j))
#define XB_XSUB(j)  (1280 + 64 * (j))
#define XB_XGEN(j)  (2304 + 64 * (j))
#define XB_TOP      3328
#define XB_TOPGEN   3392
#define XCD_BAR_WORDS 3456
#define XB_SPIN_CAP (1u << 18)
__device__ __forceinline__ unsigned xb_ld(unsigned* p)              { return __hip_atomic_load(p, __ATOMIC_RELAXED, __HIP_MEMORY_SCOPE_AGENT); }
__device__ __forceinline__ unsigned xb_add(unsigned* p, unsigned v) { return __hip_atomic_fetch_add(p, v, __ATOMIC_RELAXED, __HIP_MEMORY_SCOPE_AGENT); }
__device__ __forceinline__ unsigned xb_xcc_id() { return (unsigned)__builtin_amdgcn_s_getreg((3 << 11) | 20) & 0xFu; }
#define XB_SPIN(cond, bar) do { unsigned _sp = 0; while (cond) { __builtin_amdgcn_s_sleep(1); \
    if ((++_sp & 255u) == 0u) { if (xb_ld(&(bar)[XB_TMO])) break; if (_sp > XB_SPIN_CAP) { atomicAdd(&(bar)[XB_TMO], 1u); break; } } } } while (0)
struct XcdBarrier { unsigned* bar; unsigned x; volatile LAS unsigned* st; };
__device__ __forceinline__ XcdBarrier xcd_barrier_post(unsigned* bar, volatile LAS unsigned* st) {
    XcdBarrier b; b.bar = bar; b.x = xb_xcc_id(); b.st = st;
    if (threadIdx.x == 0) (void)xb_add(&bar[XB_XCNT(b.x)], 1u);
    return b;
}
__device__ __forceinline__ void xcd_barrier_complete(unsigned* bar, unsigned x, unsigned& nloc, unsigned& nx) {
    const unsigned G = gridDim.x * gridDim.y * gridDim.z;
    unsigned sum, cnt, mine, sp = 0u;
    for (;;) {
        sum = 0u; cnt = 0u; mine = 0u;
#pragma unroll
        for (unsigned j = 0; j < 16; ++j) { const unsigned c = xb_ld(&bar[XB_XCNT(j)]); sum += c; cnt += (c > 0u) ? 1u : 0u; mine = (j == x) ? c : mine; }
        if (sum == G) break;
        __builtin_amdgcn_s_sleep(1);
        if ((++sp & 255u) == 0u) { if (xb_ld(&bar[XB_TMO])) break; if (sp > XB_SPIN_CAP) { atomicAdd(&bar[XB_TMO], 1u); break; } }
    }
    nloc = mine > 0u ? mine : 1u; nx = cnt > 0u ? cnt : 1u;
}
__device__ __forceinline__ void xcd_barrier(const XcdBarrier& b) {
    asm volatile("s_waitcnt vmcnt(0)" ::: "memory");
    __syncthreads();
    if (threadIdx.x == 0) {
        unsigned* bar = b.bar;
        __builtin_amdgcn_s_waitcnt(0);
        unsigned nloc = b.st[0], nx = b.st[1];
        if (nloc == 0u) { xcd_barrier_complete(bar, b.x, nloc, nx); b.st[0] = nloc; b.st[1] = nx; }
        const unsigned old = xb_add(&bar[XB_XSUB(b.x)], 1u);
        const unsigned gen = old / nloc;
        if (old + 1u == (gen + 1u) * nloc) {
            __builtin_amdgcn_fence(__ATOMIC_RELEASE, "agent");
            asm volatile("s_waitcnt vmcnt(0)" ::: "memory");
            const unsigned og = xb_add(&bar[XB_TOP], 1u);
            const unsigned tg = og / nx;
            if (og + 1u == (tg + 1u) * nx) xb_add(&bar[XB_TOPGEN], 1u);
            else XB_SPIN(xb_ld(&bar[XB_TOPGEN]) == tg, bar);
            __builtin_amdgcn_fence(__ATOMIC_ACQUIRE, "agent");
            xb_add(&bar[XB_XGEN(b.x)], 1u);
            asm volatile("s_waitcnt vmcnt(0)" ::: "memory");
        } else {
            XB_SPIN(xb_ld(&bar[XB_XGEN(b.x)]) == gen, bar);
            __builtin_amdgcn_fence(__ATOMIC_ACQUIRE, "agent");
            asm volatile("s_waitcnt vmcnt(0)" ::: "memory");
        }
    }
    __syncthreads();
}

namespace pg8 {
constexpr int BM = 256, BK = 64, HALF = 128, HTB = HALF * BK * 2, STAGE_BYTES = 8 * HTB, NXCD = 8, WGM = 8;
__device__ __forceinline__ int lds_byte(int r, int c) { const int st = (r >> 4) * 2 + (c >> 5), rr = r & 15, cc = c & 31, ob = rr * 64 + cc * 2; return st * 1024 + (ob ^ (((ob >> 9) & 1) << 5)); }
__device__ __forceinline__ void stage_rc(int b, int& R, int& C) { const int st = b / 1024, sb = b % 1024, swz = sb ^ (((sb >> 9) & 1) << 5); R = (st >> 1) * 16 + swz / 64; C = (st & 1) * 32 + (swz % 64) / 2; }
__device__ __forceinline__ int perm32(int rho) { const int n = rho >> 4, i = rho & 15; return 8 * (i >> 2) + 4 * n + (i & 3); }

struct Unit { const char* A; const char* B; const int* rl; int pm, pn, aux, nvalid; };

__device__ __forceinline__ bool static_unit(int i, int G, int c, int nM, int nN, int& pm, int& pn) {
    const int nwg = nM * nN; const long L = (long)i * G + c; if (L >= nwg) return false;
    int wgid = (int)L; { const int q = nwg / NXCD, r = nwg % NXCD, xcd = wgid % NXCD, off = wgid / NXCD; wgid = (xcd < r ? xcd * (q + 1) : r * (q + 1) + (xcd - r) * q) + off; }
    const int nig = WGM * nN, gid = wgid / nig, fm = gid * WGM, gsz = (nM - fm) < WGM ? (nM - fm) : WGM;
    pm = fm + ((wgid % nig) % gsz); pn = (wgid % nig) / gsz; return true;
}
struct StaticOrder {
    const char* A; const char* Bt; int nM, nN, G, c; size_t tstepA, tstepB;
    __device__ __forceinline__ void init(const void* A_, const void* Bt_, int M, int N, int K, int G_, int c_) { A = (const char*)A_; Bt = (const char*)Bt_; nM = M / BM; nN = N / BM; G = G_; c = c_; tstepA = (size_t)BM * K * 2; tstepB = tstepA; }
    __device__ __forceinline__ bool next(int i, Unit& u) const {
        int pm, pn; if (!static_unit(i, G, c, nM, nN, pm, pn)) return false;
        u.pm = pm; u.pn = pn; u.aux = 0; u.rl = nullptr; u.nvalid = 256; u.A = A + (size_t)pm * tstepA; u.B = Bt + (size_t)pn * tstepB; return true;
    }
};

__device__ __forceinline__ void glds16(unsigned voff, const void* sbase, unsigned lds_addr) {
    unsigned keep;
    asm volatile("s_mov_b32 %0, m0\n\ts_mov_b32 m0, %3\n\ts_nop 0\n\tglobal_load_lds_dwordx4 %1, %2\n\ts_mov_b32 m0, %0" : "=&s"(keep) : "v"(voff), "s"(sbase), "s"(lds_addr) : "memory");
}
__device__ __forceinline__ void glds4(unsigned voff, const void* sbase, unsigned lds_addr) {
    unsigned keep;
    asm volatile("s_mov_b32 %0, m0\n\ts_mov_b32 m0, %3\n\ts_nop 0\n\tglobal_load_lds_dword %1, %2\n\ts_mov_b32 m0, %0" : "=&s"(keep) : "v"(voff), "s"(sbase), "s"(lds_addr) : "memory");
}
template <bool FP8, int SCW, int SCX, bool GATHER, class Epi, class Sched>
__device__ __forceinline__ void gemm_phase(LAS unsigned char* lds, LAS int* rlbuf, const int K, const size_t hstepB, const Sched& S, const Epi& E, unsigned* early = nullptr, const bool sig = false) {
    const int tid = threadIdx.x, wid = __builtin_amdgcn_readfirstlane(tid >> 6), lane = tid & 63, wr = wid >> 2, wc = wid & 3, fr = lane & 15, fq = lane >> 4;
    const int nt = K / BK;
    u32x2 vb0, vb1; unsigned vc[2][2], vn[2][2]; int gR[2], gC[2];
#pragma unroll
    for (int i = 0; i < 2; ++i) { int R, C; stage_rc(tid * 16 + i * 8192, R, C);
        gR[i] = R; gC[i] = C * 2; vb0[i] = (unsigned)(Epi::browh(R, 0) * K + C) * 2u; vb1[i] = (unsigned)(Epi::browh(R, 1) * K + C) * 2u;
#pragma unroll
        for (int h = 0; h < 2; ++h) { vc[h][i] = (unsigned)((R + h * HALF) * K + C) * 2u; vn[h][i] = vc[h][i]; } }
    const size_t kstep = (size_t)(BK * 2);
    const unsigned ldsw = (unsigned)wid * 1024u;
    const int aoff = lds_byte(wr * 64 + fr, fq * 8), boff = lds_byte(wc * 32 + fr, fq * 8);
    LAS unsigned char* ldsA = lds + aoff; LAS unsigned char* ldsB = lds + 4 * HTB + boff;
    asm volatile("" : "+v"(ldsA), "+v"(ldsB));
#define PG8_SA(b, h) (((b) * 2 + (h)) * HTB)
#define PG8_SB(b, h) ((4 + (b) * 2 + (h)) * HTB)
#define PG8_STAGE(bufoff, gbase, voff) do { _Pragma("unroll") for (int _i = 0; _i < 2; ++_i) \
        glds16((voff)[_i], (const void*)(gbase), (unsigned)(uintptr_t)(lds + (bufoff) + ldsw + _i * 8192)); } while (0)
#define PG8_STAGEA(bufoff, gbase, vo) do { _Pragma("unroll") for (int _i = 0; _i < 2; ++_i) \
        glds16((vo)[_i], (const void*)(gbase), (unsigned)(uintptr_t)(lds + (bufoff) + ldsw + _i * 8192)); } while (0)
#define PG8_RLREAD(dst, buf, nv) do { _Pragma("unroll") for (int _h = 0; _h < 2; ++_h) _Pragma("unroll") for (int _i = 0; _i < 2; ++_i) { const int _r = gR[_i] + _h * HALF; \
        const int _t = (_r < (nv)) ? rlbuf[(buf) * 256 + _r] : 0; dst[_h][_i] = (unsigned)_t * (unsigned)(K * 2) + (unsigned)gC[_i]; } } while (0)
#define PG8_LD8(base, off) __builtin_shufflevector(*(const LAS i32x4*)((base) + (off)), *(const LAS i32x4*)((base) + (off) + 1024), 0, 1, 2, 3, 4, 5, 6, 7)
#define PG8_LDA(dst, b, h) do { _Pragma("unroll") for (int m = 0; m < 4; ++m) dst[m] = PG8_LD8(ldsA, ((b) * 2 + (h)) * HTB + m * 2048); } while (0)
#define PG8_LDB(dst, b, h) do { _Pragma("unroll") for (int n = 0; n < 2; ++n) dst[n] = PG8_LD8(ldsB, ((b) * 2 + (h)) * HTB + n * 2048); } while (0)
#define PG8_H0(x) ((bf16x8)__builtin_shufflevector(x, x, 0, 1, 2, 3))
#define PG8_H1(x) ((bf16x8)__builtin_shufflevector(x, x, 4, 5, 6, 7))
#define PG8_MMA(ai, bj, At, Bt) do { __builtin_amdgcn_s_setprio(1); _Pragma("unroll") for (int m = 0; m < 4; ++m) _Pragma("unroll") for (int n = 0; n < 2; ++n) { \
        if constexpr (FP8) asm volatile("v_mfma_scale_f32_16x16x128_f8f6f4 %0, %1, %2, %0, %3, %4 op_sel_hi:[0,0,0]" : "+v"(acc[ai][bj][m][n]) : "v"(Bt[n]), "v"(At[m]), "v"(scw), "v"(scx)); \
        else { acc[ai][bj][m][n] = __builtin_amdgcn_mfma_f32_16x16x32_bf16(PG8_H0(Bt[n]), PG8_H0(At[m]), acc[ai][bj][m][n], 0, 0, 0); \
               acc[ai][bj][m][n] = __builtin_amdgcn_mfma_f32_16x16x32_bf16(PG8_H1(Bt[n]), PG8_H1(At[m]), acc[ai][bj][m][n], 0, 0, 0); } } \
        __builtin_amdgcn_s_setprio(0); } while (0)
#define PG8_WAIT_V(n) asm volatile("s_waitcnt vmcnt(" #n ")" ::: "memory")
#define PG8_WAIT_L(n) asm volatile("s_waitcnt lgkmcnt(" #n ")" ::: "memory")
#define PG8_BAR __builtin_amdgcn_s_barrier()
#define PG8_SCHED __builtin_amdgcn_sched_barrier(0)
    Unit cur, nxt; int ui = 0;
    if (!S.next(0, cur)) return;
    int scw = SCW, scx = SCX;
    if constexpr (FP8) asm volatile("" : "+v"(scw), "+v"(scx));
    f32x4 acc[2][2][4][2];
#pragma unroll
    for (int a = 0; a < 2; ++a)
#pragma unroll
        for (int b = 0; b < 2; ++b)
#pragma unroll
            for (int m = 0; m < 4; ++m)
#pragma unroll
                for (int n = 0; n < 2; ++n) acc[a][b][m][n] = (f32x4){0.f, 0.f, 0.f, 0.f};
    i32x8 At[4], B0[2], B1[2];
    const char* cA = cur.A; const char* cB = cur.B;
    if constexpr (GATHER) {
        if (tid < 256) rlbuf[tid] = cur.rl[tid];
        __syncthreads();
        PG8_RLREAD(vc, 0, cur.nvalid);
    }
    PG8_STAGE(PG8_SB(0, 0), cB, vb0); PG8_STAGE(PG8_SB(0, 1), cB + hstepB, vb1); PG8_STAGEA(PG8_SA(0, 0), cA, vc[0]); PG8_STAGEA(PG8_SA(0, 1), cA, vc[1]);
    if (wr == 1) PG8_BAR;
    PG8_WAIT_V(2); PG8_BAR;
    PG8_STAGE(PG8_SB(1, 0), cB + kstep, vb0); PG8_STAGEA(PG8_SA(1, 0), cA + kstep, vc[0]); PG8_STAGE(PG8_SB(1, 1), cB + hstepB + kstep, vb1);
    PG8_WAIT_V(6); PG8_BAR;
    for (;;) {
        const bool has_next = S.next(ui + 1, nxt);
        const char* nA = has_next ? nxt.A : cA; const char* nB = has_next ? nxt.B : cB;
        if constexpr (GATHER) { if (has_next && tid < 256) glds4((unsigned)lane * 4u, (const void*)(nxt.rl + wid * 64), (unsigned)(uintptr_t)(rlbuf + ((ui + 1) & 1) * 256 + wid * 64)); }
#pragma unroll 1
        for (int t = 0; t < nt; t += 2) {
            const bool last = (t == nt - 2);
            const char* a1 = cA + (size_t)(t + 1) * kstep;
            const char* a2 = last ? nA : cA + (size_t)(t + 2) * kstep; const char* b2 = last ? nB : cB + (size_t)(t + 2) * kstep;
            const char* a3 = a2 + kstep; const char* b3 = b2 + kstep;
            if (sig && last && !has_next && tid == 0) __hip_atomic_fetch_add(early, 1u, __ATOMIC_RELAXED, __HIP_MEMORY_SCOPE_AGENT);
            if constexpr (GATHER) { if (last && has_next) PG8_RLREAD(vn, (ui + 1) & 1, nxt.nvalid); }
            unsigned v0[2], v1[2];
#pragma unroll
            for (int i = 0; i < 2; ++i) { v0[i] = (GATHER && last) ? vn[0][i] : vc[0][i]; v1[i] = (GATHER && last) ? vn[1][i] : vc[1][i]; }
            const bool lenient = (t == 0) && (ui > 0);
            PG8_LDB(B0, 0, 0); PG8_LDB(B1, 0, 1); PG8_SCHED; PG8_LDA(At, 0, 0); PG8_STAGEA(PG8_SA(1, 1), a1, vc[1]);
            if (!lenient) PG8_WAIT_V(8);
            PG8_WAIT_L(0); PG8_BAR; PG8_MMA(0, 0, At, B0); PG8_MMA(0, 1, At, B1); PG8_BAR; PG8_SCHED;
            PG8_LDA(At, 0, 1); PG8_STAGE(PG8_SB(0, 0), b2, vb0); PG8_STAGE(PG8_SB(0, 1), b2 + hstepB, vb1); PG8_STAGEA(PG8_SA(0, 0), a2, v0);
            if (!lenient) PG8_WAIT_V(8);
            PG8_WAIT_L(0); PG8_BAR; PG8_MMA(1, 0, At, B0); PG8_MMA(1, 1, At, B1); PG8_BAR; PG8_SCHED;
            PG8_LDB(B0, 1, 0); PG8_LDB(B1, 1, 1); PG8_SCHED; PG8_LDA(At, 1, 0); PG8_STAGEA(PG8_SA(0, 1), a2, v1);
            PG8_WAIT_V(8); PG8_WAIT_L(0); PG8_BAR; PG8_MMA(0, 0, At, B0); PG8_MMA(0, 1, At, B1); PG8_BAR; PG8_SCHED;
            PG8_LDA(At, 1, 1); PG8_STAGE(PG8_SB(1, 0), b3, vb0); PG8_STAGE(PG8_SB(1, 1), b3 + hstepB, vb1); PG8_STAGEA(PG8_SA(1, 0), a3, v0);
            PG8_WAIT_V(8); PG8_WAIT_L(0); PG8_BAR; PG8_MMA(1, 0, At, B0); PG8_MMA(1, 1, At, B1); PG8_BAR; PG8_SCHED;
        }
        if (wr == 0) PG8_BAR;
        if constexpr (FP8) asm volatile("s_nop 15\n\ts_nop 15" ::: "memory");
        if constexpr (Epi::NEEDS_DRAIN) PG8_WAIT_V(0);
        { int fr_ = fr, fq_ = fq; asm volatile("" : "+v"(fr_), "+v"(fq_));
          E(acc, cur, wr, wc, fr_, fq_); }
        if (!has_next) break;
#pragma unroll
        for (int a = 0; a < 2; ++a)
#pragma unroll
            for (int b = 0; b < 2; ++b)
#pragma unroll
                for (int m = 0; m < 4; ++m)
#pragma unroll
                    for (int n = 0; n < 2; ++n) acc[a][b][m][n] = (f32x4){0.f, 0.f, 0.f, 0.f};
        cur = nxt; cA = nA; cB = nB; ++ui;
        if constexpr (GATHER) {
#pragma unroll
            for (int h = 0; h < 2; ++h)
#pragma unroll
                for (int i = 0; i < 2; ++i) vc[h][i] = vn[h][i]; }
        if (wr == 1) PG8_BAR;
    }
    PG8_WAIT_V(0);
    PG8_BAR;
#undef PG8_SA
#undef PG8_SB
#undef PG8_STAGE
#undef PG8_STAGEA
#undef PG8_RLREAD
#undef PG8_LDA
#undef PG8_LDB
#undef PG8_LD8
#undef PG8_H0
#undef PG8_H1
#undef PG8_MMA
#undef PG8_WAIT_V
#undef PG8_WAIT_L
#undef PG8_BAR
#undef PG8_SCHED
}

__device__ __forceinline__ f32x2 gelu_pk(f32x2 v) {
    const f32x2 av = __builtin_elementwise_abs(v), d = av * 0.2316418882f + 1.0f;
    f32x2 t; t.x = __builtin_amdgcn_rcpf(d.x); t.y = __builtin_amdgcn_rcpf(d.y);
    f32x2 q = t * 0.5307027145f + (-0.7265760135f); q = q * t + 0.7107068705f; q = q * t + (-0.142248368f); q = q * t + 0.127414796f; q = q * t;
    const f32x2 s = (v * v) * (-0.72134752044f);
    f32x2 e; e.x = __builtin_amdgcn_exp2f(s.x); e.y = __builtin_amdgcn_exp2f(s.y);
    const f32x2 m = v * (q * e), r = v - m;
    f32x2 o; o.x = v.x < 0.f ? m.x : r.x; o.y = v.y < 0.f ? m.y : r.y; return o;
}
struct EpiFp8 {
    static constexpr bool PERM = true, NEEDS_DRAIN = false;
    static __device__ __forceinline__ int browh(int R, int h) { return 16 * (4 * (R >> 5) + ((R & 15) >> 2)) + 8 * h + 4 * ((R >> 4) & 1) + (R & 3); }
    unsigned char* O; const float* bias;
    __device__ __forceinline__ void operator()(const f32x4 (&acc)[2][2][4][2], const Unit& u, int wr, int wc, int fr, int fq) const {
        const int row0 = u.pm * BM + wr * 64 + fr, col0 = u.pn * BM + 16 * (4 * wc + fq);
        const float* bb = bias + (size_t)u.aux * 1024 + col0;
        f32x4 bv[2][2];
#pragma unroll
        for (int bj = 0; bj < 2; ++bj)
#pragma unroll
            for (int n = 0; n < 2; ++n) bv[bj][n] = *(const f32x4*)(bb + 8 * bj + 4 * n);
#pragma unroll
        for (int ai = 0; ai < 2; ++ai)
#pragma unroll
            for (int m = 0; m < 4; ++m) { u32x4 w;
#pragma unroll
                for (int bj = 0; bj < 2; ++bj) { const f32x4 v0 = (acc[ai][bj][m][0] + bv[bj][0]) * F8_SY, v1 = (acc[ai][bj][m][1] + bv[bj][1]) * F8_SY;
                    w[2 * bj] = pk_fp8x4(v0[0], v0[1], v0[2], v0[3]); w[2 * bj + 1] = pk_fp8x4(v1[0], v1[1], v1[2], v1[3]); }
                *(u32x4*)(O + (size_t)(row0 + ai * HALF + m * 16) * 1024 + col0) = w; }
    }
};
struct EpiGeluV {
    static constexpr bool PERM = true, NEEDS_DRAIN = false; static __device__ __forceinline__ int browh(int R, int) { return (R & ~31) + perm32(R & 31); }
    bf16_t* O; const float* bias; float* vss;
    __device__ __forceinline__ void operator()(const f32x4 (&acc)[2][2][4][2], const Unit& u, int wr, int wc, int fr, int fq) const {
        const int row0 = u.pm * BM + wr * 64 + fr, col0 = u.pn * BM + wc * 32 + 8 * fq;
        f32x4 bv[2][2];
#pragma unroll
        for (int bj = 0; bj < 2; ++bj)
#pragma unroll
            for (int n = 0; n < 2; ++n) bv[bj][n] = *(const f32x4*)(bias + col0 + bj * HALF + 4 * n);
#pragma unroll
        for (int ai = 0; ai < 2; ++ai)
#pragma unroll
            for (int m = 0; m < 4; ++m) { const int row = row0 + ai * HALF + m * 16; bf16_t* rowp = O + (size_t)row * 4096 + col0; float ssq = 0.f;
                if (u.pn < 8) {
#pragma unroll
                    for (int bj = 0; bj < 2; ++bj) { const f32x4 v0 = acc[ai][bj][m][0] + bv[bj][0], v1 = acc[ai][bj][m][1] + bv[bj][1];
                        u32x4 w; w.x = cvt_pk_bf16(v0[0], v0[1]); w.y = cvt_pk_bf16(v0[2], v0[3]); w.z = cvt_pk_bf16(v1[0], v1[1]); w.w = cvt_pk_bf16(v1[2], v1[3]);
                        *(u32x4*)(rowp + bj * HALF) = w; }
                    continue; }
#pragma unroll
                for (int bj = 0; bj < 2; ++bj) { f32x4 v0 = acc[ai][bj][m][0] + bv[bj][0], v1 = acc[ai][bj][m][1] + bv[bj][1];
                    const f32x2 a = gelu_pk((f32x2){v0[0], v0[1]}), b = gelu_pk((f32x2){v0[2], v0[3]}), c = gelu_pk((f32x2){v1[0], v1[1]}), d = gelu_pk((f32x2){v1[2], v1[3]});
                    ssq += (a.x * a.x + a.y * a.y) + (b.x * b.x + b.y * b.y) + (c.x * c.x + c.y * c.y) + (d.x * d.x + d.y * d.y);
                    u32x4 w; w.x = cvt_pk_bf16(a.x, a.y); w.y = cvt_pk_bf16(b.x, b.y); w.z = cvt_pk_bf16(c.x, c.y); w.w = cvt_pk_bf16(d.x, d.y);
                    *(u32x4*)(rowp + bj * HALF) = w; }
                ssq += __shfl_xor(ssq, 16); ssq += __shfl_xor(ssq, 32); if (fq == 0) vss[(size_t)row * 32 + (u.pn - 8) * 4 + wc] = ssq; }
    }
};
struct EpiQKV {
    static constexpr bool PERM = true, NEEDS_DRAIN = false;
    static __device__ __forceinline__ int browh(int R, int) { return (R & ~0x30) | ((R & 0x10) << 1) | ((R & 0x20) >> 1); }
    bf16_t* Qb; bf16_t* Kb; bf16_t* Vb; const float* qgain; const float* kgain; LAS float* P;
    __device__ __forceinline__ void operator()(const f32x4 (&acc)[2][2][4][2], const Unit& u, int wr, int wc, int fr, int fq) const {
        const int b = u.pm / 9, jt = u.pm - 9 * b; const bool lat = jt != 0;
        const int d0 = 64 * (wc >> 1) + 16 * (wc & 1) + 4 * fq;
        { const float* gsrc = (u.pn < 4 ? qgain : kgain) + d0; const f32x4 keep = *(const f32x4*)gsrc; asm volatile("" :: "v"(keep)); }
        if (u.pn < 5) {
#pragma unroll
            for (int ai = 0; ai < 2; ++ai)
#pragma unroll
                for (int m = 0; m < 4; ++m)
#pragma unroll
                    for (int bj = 0; bj < 2; ++bj) { const f32x4 x0 = acc[ai][bj][m][0], x1 = acc[ai][bj][m][1];
                        float ss = (x0[0] * x0[0] + x0[1] * x0[1]) + (x0[2] * x0[2] + x0[3] * x0[3]) + (x1[0] * x1[0] + x1[1] * x1[1]) + (x1[2] * x1[2] + x1[3] * x1[3]);
                        { const auto r_ = __builtin_amdgcn_permlane16_swap(__float_as_uint(ss), __float_as_uint(ss), false, false); ss = __uint_as_float(r_[0]) + __uint_as_float(r_[1]); }
                        { const auto r_ = __builtin_amdgcn_permlane32_swap(__float_as_uint(ss), __float_as_uint(ss), false, false); ss = __uint_as_float(r_[0]) + __uint_as_float(r_[1]); }
                        if (fq == 0) P[(ai * HALF + wr * 64 + m * 16 + fr) * 8 + bj * 4 + wc] = ss; }
        }
        asm volatile("s_waitcnt lgkmcnt(0)" ::: "memory"); __builtin_amdgcn_s_barrier(); asm volatile("" ::: "memory");
        const f32x4 g0 = *(const f32x4*)((u.pn < 4 ? qgain : kgain) + d0), g1 = *(const f32x4*)((u.pn < 4 ? qgain : kgain) + d0 + 32);
        const int fbase = 16 * (wc & 1) + 4 * fq;
        float ifr[4];
#pragma unroll
        for (int j = 0; j < 4; ++j) ifr[j] = __builtin_amdgcn_exp2f(-(float)(fbase + j) * (13.287712379549449f / 32.0f)) * 0.15915494309189535f;
#pragma unroll
        for (int ai = 0; ai < 2; ++ai)
#pragma unroll
            for (int m = 0; m < 4; ++m) {
                const int rl = ai * HALF + wr * 64 + m * 16 + fr;
                float cs[4], sn[4];
                if (u.pn < 5 && lat) { const int t = (jt - 1) * 256 + rl; const float pos = (float)((wc >> 1) ? (t & 63) : (t >> 6));
#pragma unroll
                    for (int j = 0; j < 4; ++j) { const float a = pos * ifr[j], r = a - floorf(a); cs[j] = __builtin_amdgcn_cosf(r); sn[j] = __builtin_amdgcn_sinf(r); } }
                else {
#pragma unroll
                    for (int j = 0; j < 4; ++j) { cs[j] = 1.f; sn[j] = 0.f; } }
#pragma unroll
                for (int bj = 0; bj < 2; ++bj) {
                    f32x4 x0 = acc[ai][bj][m][0], x1 = acc[ai][bj][m][1];
                    if (u.pn < 5) { const f32x4 pp = *(const LAS f32x4*)(P + rl * 8 + bj * 4); const float rstd = rsqrtf(((pp[0] + pp[1]) + (pp[2] + pp[3])) * (1.0f / 128.0f) + NORM_EPS);
                        x0 = x0 * rstd * g0; x1 = x1 * rstd * g1;
                        f32x4 o0, o1;
#pragma unroll
                        for (int j = 0; j < 4; ++j) { o0[j] = x0[j] * cs[j] - x1[j] * sn[j]; o1[j] = x1[j] * cs[j] + x0[j] * sn[j]; }
                        x0 = o0; x1 = o1; }
                    if (u.pn < 5) {
                        unsigned char* dst = (u.pn < 4) ? (unsigned char*)Qb + (((size_t)(b * 8 + 2 * u.pn + bj) * LSEQ) + (size_t)(jt - 1) * 256 + rl) * 128 : (unsigned char*)Kb + (((size_t)(b * 2 + bj) * TBR) + (size_t)jt * 256 + rl) * 128;
                        u32x2 q8; q8.x = pk_fp8x4(x0[0] * 16.f, x0[1] * 16.f, x0[2] * 16.f, x0[3] * 16.f); q8.y = pk_fp8x4(x1[0] * 16.f, x1[1] * 16.f, x1[2] * 16.f, x1[3] * 16.f);
                        *(u32x2*)(dst + 32 * wc + 8 * fq) = q8;
                    } else {
                        unsigned char* dst = (unsigned char*)Vb + (((size_t)(b * 2 + bj) * TBR) + (size_t)jt * 256 + rl) * 128 + d0;
                        *(unsigned*)dst = pk_fp8x4(x0[0] * 16.f, x0[1] * 16.f, x0[2] * 16.f, x0[3] * 16.f); *(unsigned*)(dst + 32) = pk_fp8x4(x1[0] * 16.f, x1[1] * 16.f, x1[2] * 16.f, x1[3] * 16.f); }
                }
            }
    }
};
struct QkvOrder {
    const char* A; const char* Bt; int G, c; size_t tstep;
    __device__ __forceinline__ bool next(int i, Unit& u) const {
        constexpr int nwg = 400; const long L = (long)i * G + c; if (L >= nwg) return false;
        int wgid = (int)L; { const int q = nwg / NXCD, r = nwg % NXCD, xcd = wgid % NXCD, off = wgid / NXCD; wgid = (xcd < r ? xcd * (q + 1) : r * (q + 1) + (xcd - r) * q) + off; }
        int pm, pn;
        if (wgid < 256) { const int pl = wgid >> 2; pn = wgid & 3; pm = (pl >> 3) * 9 + 1 + (pl & 7); } else { const int idx = wgid - 256; pm = idx >> 1; pn = 4 + (idx & 1); }
        u.pm = pm; u.pn = pn; u.aux = 0; u.rl = nullptr; u.nvalid = 256; u.A = A + (size_t)pm * tstep; u.B = Bt + (size_t)pn * tstep; return true;
    }
};
template <int MODE> struct EpiResid {
    static constexpr bool PERM = true, NEEDS_DRAIN = false; static __device__ __forceinline__ int browh(int R, int) { return (R & ~31) + perm32(R & 31); }
    const float* xin; const float* cin; const bf16_t* base1; const float* mod; bf16_t* out;
    __device__ __forceinline__ void operator()(const f32x4 (&acc)[2][2][4][2], const Unit& u, int wr, int wc, int fr, int fq) const {
        const float* base = nullptr; const float* gate;
        if (MODE == 0) { const int b = u.pm / 9, j = u.pm - 9 * b; base = (j == 0) ? cin + (size_t)b * CTXL * DM : xin + ((size_t)b * LSEQ + (size_t)(j - 1) * 256) * DM; gate = mod + (size_t)((j == 0) ? 8 : b) * 6144 + 2048; }
        else { gate = mod + (size_t)(9 + u.pm / 8) * 6144 + 2048; }
        const int rl0 = wr * 64 + fr, col0 = u.pn * BM + wc * 32 + 8 * fq;
        f32x4 gv[2][2];
#pragma unroll
        for (int bj = 0; bj < 2; ++bj)
#pragma unroll
            for (int n = 0; n < 2; ++n) gv[bj][n] = *(const f32x4*)(gate + col0 + bj * HALF + 4 * n);
#pragma unroll
        for (int ai = 0; ai < 2; ++ai)
#pragma unroll
            for (int m = 0; m < 4; ++m) { const int rl = rl0 + ai * HALF + m * 16; const size_t ro = ((size_t)u.pm * 256 + rl) * DM + col0;
#pragma unroll
                for (int bj = 0; bj < 2; ++bj) { f32x4 b0, b1;
                    if (MODE == 0) { const float* bp = base + (size_t)rl * DM + col0 + bj * HALF; b0 = *(const f32x4*)bp; b1 = *(const f32x4*)(bp + 4); }
                    else { const u32x4 bw = *(const u32x4*)(base1 + ro + bj * HALF); b0 = (f32x4){bf_lo(bw.x), bf_hi(bw.x), bf_lo(bw.y), bf_hi(bw.y)}; b1 = (f32x4){bf_lo(bw.z), bf_hi(bw.z), bf_lo(bw.w), bf_hi(bw.w)}; }
                    const f32x4 v0 = b0 + gv[bj][0] * acc[ai][bj][m][0], v1 = b1 + gv[bj][1] * acc[ai][bj][m][1];
                    u32x4 w; w.x = cvt_pk_bf16(v0[0], v0[1]); w.y = cvt_pk_bf16(v0[2], v0[3]); w.z = cvt_pk_bf16(v1[0], v1[1]); w.w = cvt_pk_bf16(v1[2], v1[3]);
                    *(u32x4*)(out + ro + bj * HALF) = w; } }
    }
};
struct EpiSwiglu {
    static constexpr bool PERM = true, NEEDS_DRAIN = false; static __device__ __forceinline__ int browh(int R, int) { return (R & ~31) + perm32(R & 31); }
    unsigned char* O; const float* bias;
    static __device__ __forceinline__ f32x2 sw2(f32x2 g, f32x2 u) {
        g.x = fminf(g.x, 7.0f); g.y = fminf(g.y, 7.0f); u.x = __builtin_amdgcn_fmed3f(u.x, -7.0f, 7.0f); u.y = __builtin_amdgcn_fmed3f(u.y, -7.0f, 7.0f);
        const f32x2 t = g * (-1.702f * 1.4426950408889634f); f32x2 e; e.x = __builtin_amdgcn_exp2f(t.x); e.y = __builtin_amdgcn_exp2f(t.y);
        const f32x2 d = e + 1.0f; f32x2 r; r.x = __builtin_amdgcn_rcpf(d.x); r.y = __builtin_amdgcn_rcpf(d.y);
        return (g * r) * (u * F8_SA + F8_SA);
    }
    __device__ __forceinline__ void operator()(const f32x4 (&acc)[2][2][4][2], const Unit& u, int wr, int wc, int fr, int fq) const {
        const int row0 = u.pm * BM + wr * 64 + fr, cl = wc * 32 + 8 * fq, col0 = u.pn * 128 + cl;
        const float* bb = bias + (size_t)u.aux * 2048 + col0;
        f32x4 bg[2], bu[2];
#pragma unroll
        for (int n = 0; n < 2; ++n) { bg[n] = *(const f32x4*)(bb + 4 * n); bu[n] = *(const f32x4*)(bb + 1024 + 4 * n); }
#pragma unroll
        for (int ai = 0; ai < 2; ++ai)
#pragma unroll
            for (int m = 0; m < 4; ++m) { unsigned char* rowp = O + (size_t)(row0 + ai * HALF + m * 16) * 1024 + col0; u32x2 w;
#pragma unroll
                for (int n = 0; n < 2; ++n) { const f32x4 g4 = acc[ai][0][m][n] + bg[n], u4 = acc[ai][1][m][n] + bu[n];
                    const f32x2 a = sw2((f32x2){g4[0], g4[1]}, (f32x2){u4[0], u4[1]}), c = sw2((f32x2){g4[2], g4[3]}, (f32x2){u4[2], u4[3]});
                    int pk = __builtin_amdgcn_cvt_pk_fp8_f32(a.x, a.y, 0, false); pk = __builtin_amdgcn_cvt_pk_fp8_f32(c.x, c.y, pk, true);
                    w[n] = (unsigned)pk; }
                *(u32x2*)rowp = w; }
    }
};
}

struct MoeOrder {
    const char* A; const char* W; const LAS int* tb; const LAS int* cnt; const int* list; int nM, NPN, G, c; size_t tstepA, wstride, pnstride;
    __device__ __forceinline__ bool next(int i, pg8::Unit& u) const {
        const int nwg = nM * NPN; const long L = (long)i * G + c; if (L >= nwg) return false;
        int wgid = (int)L; { const int q = nwg / 8, r = nwg % 8, xcd = wgid % 8, off = wgid / 8; wgid = (xcd < r ? xcd * (q + 1) : r * (q + 1) + (xcd - r) * q) + off; }
        const int mt = wgid / NPN, pn = wgid - mt * NPN;
        int e = 0;
        for (int j = 1; j < NE; ++j) e += (tb[j] <= mt) ? 1 : 0;
        e = __builtin_amdgcn_readfirstlane(e);
        const int r0 = (mt - __builtin_amdgcn_readfirstlane(tb[e])) * 256, left = __builtin_amdgcn_readfirstlane(cnt[e]) - r0;
        u.pm = mt; u.pn = pn; u.aux = e; u.nvalid = left < 256 ? left : 256; u.rl = list ? list + (size_t)e * ECAP + r0 : nullptr;
        u.A = list ? A : A + (size_t)mt * tstepA; u.B = W + (size_t)e * wstride + (size_t)pn * pnstride; return true;
    }
};

namespace att {
constexpr int D = 128, NW = 8, QBLK = 32, KVBLK = 64;
constexpr float SCALE = 0.088388347648318440f;
constexpr float THR = 4.f;
constexpr int LDQ = 128, LDK = 128, LDO = 1024;
constexpr int VROW = 80;
constexpr size_t SHM_V = D * VROW, SHM_K = KVBLK * D, SHM_ATTN = 3 * SHM_V + 3 * SHM_K + NW * 64 * 4;
constexpr int QK_SC = 0x7b7b7b7b;
constexpr int P_SC = 0x7c7c7c7c;
#define KSWZ8(row, c) ((row) * 128 + ((((c) ^ ((row) & 7))) << 4))
#define SBAR() __builtin_amdgcn_sched_barrier(0)
__device__ __forceinline__ int crow(int r, int hi) { return (r & 3) + 8 * (r >> 2) + 4 * hi; }
__device__ __forceinline__ void partialSM(f32x16& p0, f32x16& p1, float& m_reg, float& mn, float& alpha) {
  constexpr float C = SCALE * 1.4426950408889634f;
  float pmax = p0[0];
#pragma unroll
  for (int r = 1; r < 16; ++r) pmax = fmaxf(pmax, p0[r]);
#pragma unroll
  for (int r = 0; r < 16; ++r) pmax = fmaxf(pmax, p1[r]);
  { auto rr = __builtin_amdgcn_permlane32_swap(__float_as_uint(pmax), __float_as_uint(pmax), false, false);
    pmax = fmaxf(__uint_as_float(rr[0]), __uint_as_float(rr[1])); }
  if (__builtin_expect(__all(pmax - m_reg <= THR / SCALE), 1)) { mn = m_reg; alpha = 1.f; }
  else { mn = fmaxf(m_reg, pmax); alpha = __builtin_amdgcn_exp2f((m_reg - mn) * C); m_reg = mn; }
  float mnC = 3.0f - mn * C;
#pragma unroll
  for (int r = 0; r < 16; ++r) p0[r] = fmaf(p0[r], C, mnC);
#pragma unroll
  for (int r = 0; r < 16; ++r) p1[r] = fmaf(p1[r], C, mnC);
#pragma unroll
  for (int r = 0; r < 16; ++r) p0[r] = __builtin_amdgcn_exp2f(p0[r]);
}
__device__ __forceinline__ void finishSM(f32x16& p0, f32x16& p1, float alpha, float& l_reg, i32x8& pa) {
#pragma unroll
  for (int r = 0; r < 16; ++r) p1[r] = __builtin_amdgcn_exp2f(p1[r]);
  float ps = 0;
#pragma unroll
  for (int r = 0; r < 16; ++r) ps += p0[r];
#pragma unroll
  for (int r = 0; r < 16; ++r) ps += p1[r];
  { auto rr = __builtin_amdgcn_permlane32_swap(__float_as_uint(ps), __float_as_uint(ps), false, false);
    ps = __uint_as_float(rr[0]) + __uint_as_float(rr[1]); }
  l_reg = l_reg * alpha + ps * 0.125f;
  pa[0] = (int)pk_fp8x4_nc(p0[0], p0[1], p0[2], p0[3]);   pa[1] = (int)pk_fp8x4_nc(p0[4], p0[5], p0[6], p0[7]);
  pa[2] = (int)pk_fp8x4_nc(p0[8], p0[9], p0[10], p0[11]); pa[3] = (int)pk_fp8x4_nc(p0[12], p0[13], p0[14], p0[15]);
  pa[4] = (int)pk_fp8x4_nc(p1[0], p1[1], p1[2], p1[3]);   pa[5] = (int)pk_fp8x4_nc(p1[4], p1[5], p1[6], p1[7]);
  pa[6] = (int)pk_fp8x4_nc(p1[8], p1[9], p1[10], p1[11]); pa[7] = (int)pk_fp8x4_nc(p1[12], p1[13], p1[14], p1[15]);
}
__device__ __forceinline__ void qkt(f32x16& p0, f32x16& p1, const unsigned char* Ks, const i32x8* qr, int r32, int hi) {
  p0 = f32x16{}; p1 = f32x16{};
#pragma unroll
  for (int m = 0; m < 2; ++m) { const int c0 = 4 * m + 2 * hi;
    const i32x4 a0 = *reinterpret_cast<const i32x4*>(Ks + KSWZ8(r32, c0)), a1 = *reinterpret_cast<const i32x4*>(Ks + KSWZ8(r32, c0 + 1));
    const i32x4 b0 = *reinterpret_cast<const i32x4*>(Ks + KSWZ8(32 + r32, c0)), b1 = *reinterpret_cast<const i32x4*>(Ks + KSWZ8(32 + r32, c0 + 1));
    const i32x8 ka = __builtin_shufflevector(a0, a1, 0, 1, 2, 3, 4, 5, 6, 7), kb = __builtin_shufflevector(b0, b1, 0, 1, 2, 3, 4, 5, 6, 7);
    p0 = __builtin_amdgcn_mfma_scale_f32_32x32x64_f8f6f4(ka, qr[m], p0, 0, 0, 0, QK_SC, 0, QK_SC);
    p1 = __builtin_amdgcn_mfma_scale_f32_32x32x64_f8f6f4(kb, qr[m], p1, 0, 0, 0, QK_SC, 0, QK_SC); }
}
__device__ __forceinline__ void pv_d0(f32x16* o, const unsigned char* Vt, const i32x8& pa, int r32, int hi) {
  const unsigned char* vb = Vt + r32 * VROW + 32 * hi;
#pragma unroll
  for (int d0 = 0; d0 < 4; ++d0) {
    const i32x4 b0 = *reinterpret_cast<const i32x4*>(vb + d0 * 32 * VROW), b1 = *reinterpret_cast<const i32x4*>(vb + d0 * 32 * VROW + 16);
    const i32x8 vv = __builtin_shufflevector(b0, b1, 0, 1, 2, 3, 4, 5, 6, 7);
    o[d0] = __builtin_amdgcn_mfma_scale_f32_32x32x64_f8f6f4(pa, vv, o[d0], 0, 0, 0, P_SC, 0, QK_SC); }
}
__device__ __forceinline__ void attn_dense_body(const unsigned char* __restrict__ Qb, const unsigned char* __restrict__ Kh, const unsigned char* __restrict__ Vh, unsigned char* __restrict__ Ob, int seq, char* lds) {
  const int tid = threadIdx.x, wid = tid >> 6, lane = tid & 63, r32 = lane & 31, hi = lane >> 5;
  unsigned char* V_lds = (unsigned char*)lds; unsigned char* K_lds = (unsigned char*)(lds + 3 * SHM_V);
  float* ws = (float*)(lds + 3 * SHM_V + 3 * SHM_K) + wid * 64; float* li_l = ws; float* al_l = ws + 32;
  float m_reg = -1e30f, l_reg = 0; f32x16 o[4] = {}; i32x8 qr[2];
  const unsigned char* Qw = Qb + (unsigned)(wid * QBLK + r32) * 128u + hi * 32;
#pragma unroll
  for (int m = 0; m < 2; ++m) { const i32x4 q0 = *reinterpret_cast<const i32x4*>(Qw + 64 * m), q1 = *reinterpret_cast<const i32x4*>(Qw + 64 * m + 16); qr[m] = __builtin_shufflevector(q0, q1, 0, 1, 2, 3, 4, 5, 6, 7); }
  const int vq = (lane & 7) + 8 * (wid & 3), a4 = (lane >> 3) + 8 * (wid >> 2);
  const unsigned vo = (unsigned)(4 * a4) * 128u + 4u * vq;
  const int vpos = 32 * (a4 & 1) + 16 * (a4 >> 3) + 4 * ((a4 >> 1) & 3);
  const int vst = 4 * vq * VROW + vpos;
  struct { u32x4 vs; bf16x8 ks0; } sr_[2];
  const unsigned kk = (unsigned)(tid >> 3), kch = (unsigned)(tid & 7), ko8 = kk * 128u + kch * 16u;
#define SLOAD(i, k0) do { const unsigned char* vb_ = Vh + (unsigned)(k0) * 128u; const unsigned char* kb_ = Kh + (unsigned)(k0) * 128u; \
    sr_[i].vs[0] = *reinterpret_cast<const unsigned*>(vb_ + vo); sr_[i].vs[1] = *reinterpret_cast<const unsigned*>(vb_ + vo + 128u); \
    sr_[i].vs[2] = *reinterpret_cast<const unsigned*>(vb_ + vo + 256u); sr_[i].vs[3] = *reinterpret_cast<const unsigned*>(vb_ + vo + 384u); \
    sr_[i].ks0 = *reinterpret_cast<const bf16x8*>(kb_ + ko8); } while (0)
#define SWRITE(b, i) do { const u32x4 r_ = sr_[i].vs;                                                                                          \
    const unsigned t0_ = __builtin_amdgcn_perm(r_[1], r_[0], 0x05010400u), t1_ = __builtin_amdgcn_perm(r_[1], r_[0], 0x07030602u);            \
    const unsigned t2_ = __builtin_amdgcn_perm(r_[3], r_[2], 0x05010400u), t3_ = __builtin_amdgcn_perm(r_[3], r_[2], 0x07030602u);            \
    unsigned char* vd_ = V_lds + (b) * SHM_V + vst;                                                                                            \
    *(unsigned*)(vd_) = __builtin_amdgcn_perm(t2_, t0_, 0x05040100u); *(unsigned*)(vd_ + VROW) = __builtin_amdgcn_perm(t2_, t0_, 0x07060302u); \
    *(unsigned*)(vd_ + 2 * VROW) = __builtin_amdgcn_perm(t3_, t1_, 0x05040100u); *(unsigned*)(vd_ + 3 * VROW) = __builtin_amdgcn_perm(t3_, t1_, 0x07060302u); \
    *(bf16x8*)((char*)K_lds + (b) * SHM_K + KSWZ8(kk, kch)) = sr_[i].ks0; } while (0)
#define RESC(a) do { if (__any((a) < 1.f)) { if (hi == 0) al_l[r32] = (a); asm volatile("s_waitcnt lgkmcnt(0)" ::: "memory"); \
    _Pragma("unroll") for (int d = 0; d < 4; ++d) _Pragma("unroll") for (int r = 0; r < 16; ++r) o[d][r] *= al_l[crow(r, hi)]; } } while (0)
#define STEP(PX0, PX1, ALX, PY0, PY1, MNY, ALY, J, W, L, Q) do {                                                         \
    if (W) { asm volatile("s_waitcnt vmcnt(0)" ::: "memory"); SWRITE(sW, 0); if (L) SLOAD(0, ((J) + 3) * KVBLK); }       \
    SBAR(); if (Q) qkt(PY0, PY1, K_lds + sK * SHM_K, qr, r32, hi);                                                       \
    finishSM(PX0, PX1, ALX, l_reg, pa); SBAR();                                                                          \
    pv_d0(o, V_lds + sV * SHM_V, pa, r32, hi);                                                                           \
    if (Q) { partialSM(PY0, PY1, m_reg, MNY, ALY); RESC(ALY); }                                                          \
    __syncthreads(); sV = sK; sK = sW; sW = (sW == 2) ? 0 : sW + 1; } while (0)
  f32x16 pA0, pA1, pB0, pB1; float mnA, mnB, alA, alB; i32x8 pa; const int NT = seq / KVBLK;
  int sV = 0, sK = 1, sW = 2;
  SLOAD(0, 0); SLOAD(1, KVBLK); asm volatile("s_waitcnt vmcnt(0)" ::: "memory"); SWRITE(0, 0); SWRITE(1, 1); SLOAD(0, 2 * KVBLK); __syncthreads();
  qkt(pA0, pA1, K_lds, qr, r32, hi); partialSM(pA0, pA1, m_reg, mnA, alA);
  int j = 0;
  for (; j + 4 < NT; j += 2) {
    STEP(pA0, pA1, alA, pB0, pB1, mnB, alB, j, true, true, true);
    STEP(pB0, pB1, alB, pA0, pA1, mnA, alA, j + 1, true, true, true);
  }
  STEP(pA0, pA1, alA, pB0, pB1, mnB, alB, j, true, true, true);
  STEP(pB0, pB1, alB, pA0, pA1, mnA, alA, j + 1, true, false, true);
  STEP(pA0, pA1, alA, pB0, pB1, mnB, alB, j + 2, false, false, true);
  STEP(pB0, pB1, alB, pA0, pA1, mnA, alA, j + 3, false, false, false);
  if (hi == 0) li_l[r32] = l_reg; asm volatile("s_waitcnt lgkmcnt(0)" ::: "memory");
  float rli[16];
#pragma unroll
  for (int r = 0; r < 16; ++r) rli[r] = __builtin_amdgcn_rcpf(li_l[crow(r, hi)]);
  unsigned char* Ow = Ob + (long)(wid * QBLK) * LDO + 4 * r32;
#pragma unroll
  for (int r = 0; r < 16; ++r) { const float sc = rli[r] * 16.f;
    *(unsigned*)(Ow + (long)crow(r, hi) * LDO) = pk_fp8x4(o[0][r] * sc, o[1][r] * sc, o[2][r] * sc, o[3][r] * sc); }
  __syncthreads();
#undef SLOAD
#undef SWRITE
#undef STEP
#undef RESC
}
}

struct Ctx {
    LAS unsigned char* lds; int tid, lane, wave, G, bid;
};

__device__ __forceinline__ void ada_phase(const Params& P, const Ctx& F) {
    LAS float* S = (LAS float*)F.lds;
    LAS float* red = (LAS float*)(F.lds + 36864);
    float* mod = (float*)(P.ws + WS_MOD);
    for (int i = F.tid; i < 9 * 1024; i += NTHREADS) { const float v = (i < 8192) ? P.c[i] : P.c_ctx[i - 8192]; S[i] = v / (1.0f + __expf(-v)); }
    __syncthreads();
    const int kg = F.tid >> 3, cq = F.tid & 7;
    for (int u = F.bid; u < 384; u += F.G) {
        const int l = u / 192, n0 = (u - l * 192) * 32;
        const float* W = P.ada_w + (size_t)l * 1024 * 6144 + n0 + cq * 4;
        float acc[9][4];
#pragma unroll
        for (int r = 0; r < 9; ++r)
#pragma unroll
            for (int j = 0; j < 4; ++j) acc[r][j] = 0.f;
        f32x4 wv[16];
#pragma unroll
        for (int it = 0; it < 16; ++it) wv[it] = __builtin_nontemporal_load((const f32x4*)(W + (size_t)(kg + 64 * it) * 6144));
#pragma unroll
        for (int it = 0; it < 16; ++it) {
            const int k = kg + 64 * it;
            const f32x4 w = wv[it];
#pragma unroll
            for (int r = 0; r < 9; ++r) { const float s = S[r * 1024 + k];
#pragma unroll
                for (int j = 0; j < 4; ++j) acc[r][j] = fmaf(s, w[j], acc[r][j]); }
        }
#pragma unroll
        for (int r = 0; r < 9; ++r)
#pragma unroll
            for (int j = 0; j < 4; ++j) red[kg * 288 + r * 32 + cq * 4 + j] = acc[r][j];
        __syncthreads();
        if (F.tid < 288) { float s = 0.f; for (int g = 0; g < 64; ++g) s += red[g * 288 + F.tid];
            const int r = F.tid >> 5, col = F.tid & 31; mod[((size_t)l * 9 + r) * 6144 + n0 + col] = s + P.ada_b[l * 6144 + n0 + col]; }
        __syncthreads();
    }
}

constexpr int CVT_T0 = 512, CVT_T1 = CVT_T0 + 256, CVT_T2 = CVT_T1 + 192, CVT_T3 = CVT_T2 + 128, CVT_T4 = CVT_T3 + 64 * 256, CVT_T5 = CVT_T4 + 64 * 128;
struct CvtTile { const float* src; unsigned char* dst; int K, N, f8; };
struct CvtTile8 { const float* src; unsigned char* dst; int N; };
__device__ __forceinline__ void cvt_decode_moe(const Params& P, int ql, int j, CvtTile8& d) {
    const bool gu = j < 4096; const int loc = gu ? j : j - 4096, N = gu ? 2048 : 1024, ntn = N / 128, tpm = 8 * ntn;
    const int m = loc / tpm, rem = loc - m * tpm, kt = rem / ntn, nt = rem - kt * ntn, mm = ql * 32 + m;
    size_t sdiff = (size_t)((uintptr_t)P.w_dn - (uintptr_t)P.w_gu); asm volatile("" : "+s"(sdiff));
    const float* src = (const float*)((uintptr_t)P.w_gu + (gu ? (size_t)0 : sdiff)); const size_t dof = gu ? WS_WGU : WS_WDN;
    d.src = src + (size_t)mm * 1024 * N + (size_t)kt * 128 * N + nt * 128; d.dst = P.ws + dof + (size_t)mm * 1024 * N + (size_t)nt * 128 * 1024 + kt * 128; d.N = N;
}
__device__ __forceinline__ void cvt_load8(const CvtTile8& d, int tid, f32x4 (&r)[8]) {
#pragma unroll
    for (int j = 0; j < 8; ++j) { const int idx = tid + 512 * j; r[j] = __builtin_nontemporal_load((const f32x4*)(d.src + (size_t)(idx >> 5) * d.N + (idx & 31) * 4)); }
}
__device__ __forceinline__ void cvt_tile8(const CvtTile8& d, int tid, const f32x4 (&cur)[8], LAS float* L) {
#pragma unroll
    for (int j = 0; j < 8; ++j) { const int idx = tid + 512 * j, k = idx >> 5, c4 = idx & 31; *(LAS f32x4*)(L + ((k >> 4) + 8 * (k & 15)) * 132 + 4 * c4) = cur[j]; }
    __syncthreads();
    {
#pragma unroll
    for (int j = 0; j < 2; ++j) { const int kg = tid & 7, n = (tid >> 3) + 64 * j; const LAS float* q = L + kg * 132 + n; float v[16];
#pragma unroll
        for (int jj = 0; jj < 16; ++jj) v[jj] = q[jj * 8 * 132] * F8_SW;
        u32x4 w; w.x = pk_fp8x4(v[0], v[1], v[2], v[3]); w.y = pk_fp8x4(v[4], v[5], v[6], v[7]); w.z = pk_fp8x4(v[8], v[9], v[10], v[11]); w.w = pk_fp8x4(v[12], v[13], v[14], v[15]);
        __builtin_nontemporal_store(w, (u32x4*)(d.dst + (size_t)n * 1024 + 16 * kg)); } }
    __syncthreads();
}
__device__ __forceinline__ int cvt_kperm(int k) { return 2 * (k >> 3) + (k & 1) + 32 * ((k & 7) >> 1); }
__device__ __forceinline__ void cvt_load(const CvtTile& d, int tid, f32x4 (&r)[4]) {
#pragma unroll
    for (int j = 0; j < 4; ++j) { const int idx = tid + 512 * j; r[j] = *(const f32x4*)(d.src + (size_t)(idx >> 4) * d.N + (idx & 15) * 4); }
}
__device__ __forceinline__ void cvt_tile(const CvtTile& d, int tid, const f32x4 (&cur)[4], LAS float* L) {
#pragma unroll
    for (int j = 0; j < 4; ++j) { const int idx = tid + 512 * j, k = idx >> 4, c4 = idx & 15; LAS float* p = L + cvt_kperm(k) * 65 + 4 * c4;
        p[0] = cur[j][0]; p[1] = cur[j][1]; p[2] = cur[j][2]; p[3] = cur[j][3]; }
    __syncthreads();
    if (d.f8) { const int kg = tid & 7, n = tid >> 3; float v[16];
#pragma unroll
        for (int jj = 0; jj < 16; ++jj) { const int pp = 16 * kg + jj, kk = (d.f8 == 2) ? 32 * (pp & 3) + (pp >> 2) : pp;
            v[jj] = L[cvt_kperm(kk) * 65 + n] * F8_SW; }
        u32x4 w; w.x = pk_fp8x4(v[0], v[1], v[2], v[3]); w.y = pk_fp8x4(v[4], v[5], v[6], v[7]); w.z = pk_fp8x4(v[8], v[9], v[10], v[11]); w.w = pk_fp8x4(v[12], v[13], v[14], v[15]);
        *(u32x4*)(d.dst + (size_t)n * d.K + 16 * kg) = w; }
    else {
#pragma unroll
        for (int j = 0; j < 2; ++j) { const int kg = tid & 15, n = (tid >> 4) + 32 * j; float v[8];
#pragma unroll
            for (int jj = 0; jj < 8; ++jj) v[jj] = L[cvt_kperm(8 * kg + jj) * 65 + n];
            u32x4 w; w.x = cvt_pk_bf16(v[0], v[1]); w.y = cvt_pk_bf16(v[2], v[3]); w.z = cvt_pk_bf16(v[4], v[5]); w.w = cvt_pk_bf16(v[6], v[7]);
            *(u32x4*)(d.dst + ((size_t)n * d.K + 8 * kg) * 2) = w; } }
    __syncthreads();
}
constexpr int CVT_QN = 4096 + 2048;
__device__ __forceinline__ void cvt_fill(const Params& P, const Ctx& F, int ql, const unsigned* done, int need) {
    LAS float* L = (LAS float*)F.lds;
    LAS int* mb = (LAS int*)(F.lds + 69632);
    unsigned* head = (unsigned*)(P.ws + WS_QHEAD + ql * 256);
    constexpr int LIM = CVT_QN;
    int i0, i1, i2; bool stop = false;
    __syncthreads();
    if (F.tid == 0) { const bool go = need < 0 || (int)__hip_atomic_load(done, __ATOMIC_RELAXED, __HIP_MEMORY_SCOPE_AGENT) < need;
        mb[0] = go ? (int)__hip_atomic_fetch_add(head, 3u, __ATOMIC_RELAXED, __HIP_MEMORY_SCOPE_AGENT) : LIM; }
    __syncthreads();
    i0 = mb[0]; i1 = i0 + 1; i2 = i0 + 2;
    if (i0 >= LIM) return;
    f32x4 r0[8], r1[8], r2[8]; CvtTile8 d0, d1, d2;
    cvt_decode_moe(P, ql, i0, d0); cvt_load8(d0, F.tid, r0);
    d1 = d0; d2 = d0;
    if (i1 < LIM) { cvt_decode_moe(P, ql, i1, d1); cvt_load8(d1, F.tid, r1); }
    for (;;) {
        int i3 = LIM, st = 0;
        if (F.tid == 0 && i2 < LIM && !stop) { i3 = (int)__hip_atomic_fetch_add(head, 1u, __ATOMIC_RELAXED, __HIP_MEMORY_SCOPE_AGENT); if (need >= 0) st = (int)__hip_atomic_load(done, __ATOMIC_RELAXED, __HIP_MEMORY_SCOPE_AGENT) >= need; }
        if (i2 < LIM) { cvt_decode_moe(P, ql, i2, d2); cvt_load8(d2, F.tid, r2); }
        cvt_tile8(d0, F.tid, r0, L);
        if (F.tid == 0) { mb[0] = i3; mb[1] = st; }
        __syncthreads(); i3 = mb[0]; stop = stop || (mb[1] != 0);
        if (i1 >= LIM) break;
        r0[0] = r1[0]; r0[1] = r1[1]; r0[2] = r1[2]; r0[3] = r1[3]; r0[4] = r1[4]; r0[5] = r1[5]; r0[6] = r1[6]; r0[7] = r1[7];
        r1[0] = r2[0]; r1[1] = r2[1]; r1[2] = r2[2]; r1[3] = r2[3]; r1[4] = r2[4]; r1[5] = r2[5]; r1[6] = r2[6]; r1[7] = r2[7];
        d0 = d1; d1 = d2; i0 = i1; i1 = i2; i2 = i3;
    }
}
__device__ __forceinline__ void cvt_dense_one(const Ctx& F, const float* src, unsigned char* dst, int K, int N, int f8 = 0) {
    LAS float* L = (LAS float*)F.lds; const int ntn = N / 64, ntiles = (K / 128) * ntn;
    for (int t = F.bid; t < ntiles; t += F.G) { const int kt = t / ntn, nt = t - kt * ntn; CvtTile d;
        d.src = src + (size_t)kt * 128 * N + nt * 64; d.dst = dst + ((size_t)nt * 64 * K + kt * 128) * (f8 ? 1 : 2); d.K = K; d.N = N; d.f8 = f8;
        f32x4 r[4]; cvt_load(d, F.tid, r); cvt_tile(d, F.tid, r, L); }
}
__device__ __forceinline__ void cvt_phase(const Params& P, const Ctx& F) {
    { bf16_t* rh = (bf16_t*)(P.ws + WS_RWH); bf16_t* rl = (bf16_t*)(P.ws + WS_RWL);
      for (int i = F.bid * NTHREADS + F.tid; i < 2 * 1024 * 32; i += F.G * NTHREADS) {
          const int l = i >> 15, k = (i >> 5) & 1023, e = i & 31; const float w = P.router_w[i];
          const unsigned h = cvt_pk_bf16(w, 0.f) & 0xffffu; const float rem = w - __uint_as_float(h << 16);
          rh[(l * 32 + e) * 1024 + k] = (bf16_t)h; rl[(l * 32 + e) * 1024 + k] = (bf16_t)(cvt_pk_bf16(rem, 0.f) & 0xffffu); } }
    LAS float* L = (LAS float*)F.lds; CvtTile dc; f32x4 rc[4]; bool have = false;
    dc.src = P.gm_w_in; dc.dst = P.ws + WS_WIN; dc.K = 0; dc.N = 0; dc.f8 = 0;
#define CVT_FEED(SRC, DSTOFF, K_, N_, F8_, SHIFT) do { const int ntn = (N_) / 64, ntiles = ((K_) / 128) * ntn; \
        for (int t = (F.bid + F.G - ((SHIFT) % F.G)) % F.G; t < ntiles; t += F.G) { const int kt = t / ntn, nt = t - kt * ntn; CvtTile dn; f32x4 rn[4]; \
            dn.src = (SRC) + (size_t)kt * 128 * (N_) + nt * 64; dn.dst = P.ws + (DSTOFF) + ((size_t)nt * 64 * (K_) + kt * 128) * ((F8_) ? 1 : 2); dn.K = (K_); dn.N = (N_); dn.f8 = (F8_); \
            cvt_load(dn, F.tid, rn); if (have) cvt_tile(dc, F.tid, rc, L); \
            dc = dn; rc[0] = rn[0]; rc[1] = rn[1]; rc[2] = rn[2]; rc[3] = rn[3]; have = true; } } while (0)
    CVT_FEED(P.gm_w_in, WS_WIN, 1024, 4096, 1, 0); CVT_FEED(P.gm_w_out, WS_WOUT, 2048, 1024, 0, 0); CVT_FEED(P.at_w_qkv, WS_WQKV, 1024, 1536, 1, 64); CVT_FEED(P.at_w_o, WS_WO, 1024, 1024, 2, 128);
#undef CVT_FEED
    if (have) cvt_tile(dc, F.tid, rc, L);
}
__device__ __forceinline__ unsigned* fill_done(const Params& P, int phase) { return (unsigned*)(P.ws + WS_PHDONE + phase * 256); }
__device__ __forceinline__ int fill_nlong(int nwg, int Gg) { const int r = nwg % Gg; return r == 0 ? Gg : r; }
__device__ __forceinline__ bool fill_long(const Ctx& F, int nwg, int Gg) { return F.bid < fill_nlong(nwg, Gg); }
__device__ __forceinline__ void tail_fill(const Params& P, const Ctx& F, int ql, int phase, int nwg, int Gg) {
    const int nlong = fill_nlong(nwg, Gg);
    if (F.bid < nlong || (nlong == Gg && Gg == F.G)) return;
    cvt_fill(P, F, ql, fill_done(P, phase), nlong);
    if (ql == 0) cvt_fill(P, F, 1, fill_done(P, phase), nlong);
}

__device__ __forceinline__ void norm0_phase(const Params& P, const Ctx& F) {
    const float* mod = (const float*)(P.ws + WS_MOD); unsigned char* hb = P.ws + WS_HBUF;
    const int nwaves = F.G * 8, rpw = (T + nwaves - 1) / nwaves;
    const int rbeg = (F.bid * 8 + F.wave) * rpw, rend = (rbeg + rpw < T) ? rbeg + rpw : T;
    if (rbeg >= rend) return;
    f32x4 gv[4], scv[4], shv[4]; int cur_mr = -1;
    f32x4 xn[4];
#define N0_LOAD(R) do { const float* src_ = src_row(P, (R)); _Pragma("unroll") for (int j = 0; j < 2; ++j) { xn[2 * j] = *(const f32x4*)(src_ + 8 * F.lane + 512 * j); xn[2 * j + 1] = *(const f32x4*)(src_ + 8 * F.lane + 512 * j + 4); } } while (0)
    N0_LOAD(rbeg);
    for (int r = rbeg; r < rend; ++r) {
        f32x4 v[4]; float ss = 0.f;
#pragma unroll
        for (int j = 0; j < 4; ++j) { v[j] = xn[j]; ss += (v[j][0] * v[j][0] + v[j][1] * v[j][1]) + (v[j][2] * v[j][2] + v[j][3] * v[j][3]); }
        const int mr = mod_row(r);
        if (mr != cur_mr) { cur_mr = mr; const float* md = mod + (size_t)mr * 6144;
#pragma unroll
            for (int j = 0; j < 4; ++j) { const int c = 8 * F.lane + 512 * (j >> 1) + 4 * (j & 1); gv[j] = *(const f32x4*)(P.norm_mix + c); scv[j] = *(const f32x4*)(md + 1024 + c) + 1.0f; shv[j] = *(const f32x4*)(md + c); } }
        if (r + 1 < rend) N0_LOAD(r + 1);
        ss = wave_sum(ss); const float rstd = rsqrtf(ss * (1.0f / 1024.0f) + NORM_EPS);
#pragma unroll
        for (int j = 0; j < 2; ++j) { const f32x4 h0 = (v[2 * j] * rstd) * gv[2 * j] * scv[2 * j] + shv[2 * j], h1 = (v[2 * j + 1] * rstd) * gv[2 * j + 1] * scv[2 * j + 1] + shv[2 * j + 1];
            u32x2 w; w.x = pk_fp8x4(h0[0] * F8_SX, h0[1] * F8_SX, h0[2] * F8_SX, h0[3] * F8_SX); w.y = pk_fp8x4(h1[0] * F8_SX, h1[1] * F8_SX, h1[2] * F8_SX, h1[3] * F8_SX);
            *(u32x2*)(hb + (size_t)r * 1024 + 8 * F.lane + 512 * j) = w; }
    }
#undef N0_LOAD
}

template <int OFF> __device__ __forceinline__ s16x4 tr_read_o(int vb) { s16x4 r; asm volatile("ds_read_b64_tr_b16 %0, %1 offset:%2" : "=&v"(r) : "v"(vb), "i"(OFF) : "memory"); return r; }
constexpr int SG_STRIDE = 544;
__device__ __forceinline__ int sg_off(int q, int cbyte) { return q * SG_STRIDE + (cbyte ^ (((q >> 3) & 1) << 7)); }
__device__ __forceinline__ void sgate_phase(const Params& P, const Ctx& F) {
    const bf16_t* uv = (const bf16_t*)(P.ws + WS_UV); const float* vss = (const float*)(P.ws + WS_VSS); bf16_t* tb = (bf16_t*)(P.ws + WS_TBUF);
    LAS unsigned char* Vl = F.lds;
    LAS float* rq = (LAS float*)(F.lds + 128 * SG_STRIDE);
    const int fr = F.lane & 15, fq = F.lane >> 4, pw = F.wave & 3, ch = F.wave >> 2;
    u32x4 vt[8]; float rqn = 0.f;
#define SG_LOADV(U) do { const int _c = (U) >> 3, _g = (U) & 7, _r0 = _c * 128; \
        if (F.tid < 128) { const float* p = vss + (size_t)(_r0 + F.tid) * 32; float s_ = 0.f; \
            _Pragma("unroll") for (int j = 0; j < 8; ++j) { const f32x4 a = *(const f32x4*)(p + 4 * j); s_ += (a[0] + a[1]) + (a[2] + a[3]); } \
            rqn = rsqrtf(s_ * (1.0f / 2048.0f) + NORM_EPS); } \
        _Pragma("unroll") for (int j = 0; j < 8; ++j) { const int idx = F.tid + 512 * j, q = idx >> 5, c16 = idx & 31; \
            vt[j] = *(const u32x4*)(uv + (size_t)(_r0 + q) * 4096 + 2048 + _g * 256 + c16 * 8); } } while (0)
#define SG_LOADU(U, D) do { const int _c = (U) >> 3, _g = (U) & 7; \
        _Pragma("unroll") for (int jb = 0; jb < 2; ++jb) _Pragma("unroll") for (int c2 = 0; c2 < 4; ++c2) \
            D[jb][c2] = *(const u32x4*)(uv + (size_t)(_c * 128 + 32 * pw + 16 * jb + fr) * 4096 + _g * 256 + 128 * ch + 32 * c2 + 8 * fq); } while (0)
    u32x4 un[2][4];
    if (F.bid < 144 * 8) { SG_LOADV(F.bid); if (F.tid < 128) rq[F.tid] = rqn; SG_LOADU(F.bid, un); }
    __syncthreads();
    LAS float* gl = rq + 256;
    bf16x8 wf[2][4]; float bsv0 = 0.f, bsv1 = 0.f; int cur_g = -1, rb = 0;
    for (int u = F.bid; u < 144 * 8; u += F.G, rb ^= 1) {
        const int chunk = u >> 3, g = u & 7, r0 = chunk * 128;
#pragma unroll
        for (int j = 0; j < 8; ++j) { const int idx = F.tid + 512 * j, q = idx >> 5, c16 = idx & 31; const float rs = rq[rb * 128 + q]; const u32x4 v = vt[j]; u32x4 w;
            w.x = cvt_pk_bf16(bf_lo(v.x) * rs, bf_hi(v.x) * rs); w.y = cvt_pk_bf16(bf_lo(v.y) * rs, bf_hi(v.y) * rs); w.z = cvt_pk_bf16(bf_lo(v.z) * rs, bf_hi(v.z) * rs); w.w = cvt_pk_bf16(bf_lo(v.w) * rs, bf_hi(v.w) * rs);
            *(LAS u32x4*)(Vl + sg_off(q, c16 * 16)) = w; }
        u32x4 uus[2][4];
#pragma unroll
        for (int jb = 0; jb < 2; ++jb)
#pragma unroll
            for (int c2 = 0; c2 < 4; ++c2) uus[jb][c2] = un[jb][c2];
        if (g != cur_g) { cur_g = g;
#pragma unroll
            for (int jb = 0; jb < 2; ++jb) { const float bb = P.gm_b_s[g * 128 + 32 * pw + 16 * jb + fr]; if (jb == 0) bsv0 = bb; else bsv1 = bb;
#pragma unroll
                for (int ks = 0; ks < 4; ++ks) { const float* wp = P.gm_w_s + ((size_t)g * 128 + 32 * pw + 16 * jb + fr) * 128 + 32 * ks + 8 * fq; const f32x4 a = *(const f32x4*)wp, b = *(const f32x4*)(wp + 4);
                    u32x4 w; w.x = cvt_pk_bf16(a[0], a[1]); w.y = cvt_pk_bf16(a[2], a[3]); w.z = cvt_pk_bf16(b[0], b[1]); w.w = cvt_pk_bf16(b[2], b[3]);
                    wf[jb][ks] = *reinterpret_cast<bf16x8*>(&w); } }
            if (F.tid < 256) gl[F.tid] = P.gm_v_gain[g * 256 + F.tid]; }
        if (u + F.G < 144 * 8) { SG_LOADU(u + F.G, un); SG_LOADV(u + F.G); if (F.tid < 128) rq[(rb ^ 1) * 128 + F.tid] = rqn; }
        __syncthreads();
        const int qq = fr >> 2, pp = fr & 3;
        const int vbase = (int)(uintptr_t)Vl + (8 * fq + qq) * SG_STRIDE + 256 * ch + 16 * pp;
        const int baseA = vbase + ((fq & 1) ? 128 : 0), baseB = vbase + ((fq & 1) ? 0 : 128);
#define SG_HALF(KS, C2H, XH) do { s16x4 lo[2], hi[2]; const int bs = (C2H) ? baseB : baseA; \
            lo[0] = tr_read_o<(KS) * 32 * SG_STRIDE + 64 * (XH) + 0>(bs);  hi[0] = tr_read_o<(KS) * 32 * SG_STRIDE + 4 * SG_STRIDE + 64 * (XH) + 0>(bs); \
            lo[1] = tr_read_o<(KS) * 32 * SG_STRIDE + 64 * (XH) + 8>(bs);  hi[1] = tr_read_o<(KS) * 32 * SG_STRIDE + 4 * SG_STRIDE + 64 * (XH) + 8>(bs); \
            asm volatile("s_waitcnt lgkmcnt(0)" ::: "memory"); __builtin_amdgcn_sched_barrier(0); \
            _Pragma("unroll") for (int x = 0; x < 2; ++x) { const bf16x8 vf = (bf16x8){lo[x][0], lo[x][1], lo[x][2], lo[x][3], hi[x][0], hi[x][1], hi[x][2], hi[x][3]}; \
                _Pragma("unroll") for (int jb = 0; jb < 2; ++jb) acc[jb][XH][x] = __builtin_amdgcn_mfma_f32_16x16x32_bf16(vf, wf[jb][KS], acc[jb][XH][x], 0, 0, 0); } } while (0)
#define SG_STEP(KS, C2H) do { SG_HALF(KS, C2H, 0); SG_HALF(KS, C2H, 1); } while (0)
#define SG_COLS(C2H) do { f32x4 acc[2][2][2]; \
        _Pragma("unroll") for (int jb = 0; jb < 2; ++jb) _Pragma("unroll") for (int c2 = 0; c2 < 2; ++c2) _Pragma("unroll") for (int n = 0; n < 2; ++n) acc[jb][c2][n] = (f32x4){0.f, 0.f, 0.f, 0.f}; \
        SG_STEP(0, C2H); SG_STEP(1, C2H); SG_STEP(2, C2H); SG_STEP(3, C2H); \
        _Pragma("unroll") for (int jb = 0; jb < 2; ++jb) { const int p = 32 * pw + 16 * jb + fr; const float bs = jb ? bsv1 : bsv0; \
            _Pragma("unroll") for (int c2l = 0; c2l < 2; ++c2l) { const int c2 = 2 * (C2H) + c2l, col = g * 256 + 128 * ch + 32 * c2 + 8 * fq; \
                const f32x4 g0 = *(const LAS f32x4*)(gl + 128 * ch + 32 * c2 + 8 * fq), g1 = *(const LAS f32x4*)(gl + 128 * ch + 32 * c2 + 8 * fq + 4); \
                const u32x4 uu = uus[jb][c2]; \
                const f32x4 s0 = acc[jb][c2l][0] * g0 + bs, s1 = acc[jb][c2l][1] * g1 + bs; \
                const f32x2 ua = pg8::gelu_pk((f32x2){bf_lo(uu.x), bf_hi(uu.x)}), ub = pg8::gelu_pk((f32x2){bf_lo(uu.y), bf_hi(uu.y)}), uc = pg8::gelu_pk((f32x2){bf_lo(uu.z), bf_hi(uu.z)}), ud = pg8::gelu_pk((f32x2){bf_lo(uu.w), bf_hi(uu.w)});     \
                u32x4 w; w.x = cvt_pk_bf16(ua.x * s0[0], ua.y * s0[1]); w.y = cvt_pk_bf16(ub.x * s0[2], ub.y * s0[3]); \
                w.z = cvt_pk_bf16(uc.x * s1[0], uc.y * s1[1]); w.w = cvt_pk_bf16(ud.x * s1[2], ud.y * s1[3]); \
                *(u32x4*)(tb + (size_t)(r0 + p) * 2048 + col) = w; } } } while (0)
        SG_COLS(0); SG_COLS(1);
#undef SG_COLS
#undef SG_STEP
#undef SG_HALF
        __syncthreads();
    }
#undef SG_LOADV
#undef SG_LOADU
}

template <int LAYER> __device__ __forceinline__ void route_phase(const Params& P, const Ctx& F) {
    constexpr int NROWS = LAYER == 0 ? T : TL, NT = NROWS / 32;
    const bf16_t* X = (const bf16_t*)(P.ws + (LAYER == 0 ? WS_X1 : WS_X3C));
    const float* mod = (const float*)(P.ws + WS_MOD) + (size_t)LAYER * 9 * 6144;
    const bf16_t* rwh = (const bf16_t*)(P.ws + WS_RWH) + (size_t)LAYER * 32 * 1024; const bf16_t* rwl = (const bf16_t*)(P.ws + WS_RWL) + (size_t)LAYER * 32 * 1024;
    unsigned char* fb = P.ws + WS_FBUF;
    int* cnt = (int*)(P.ws + WS_CNT + LAYER * 8192); int* list = (int*)(P.ws + WS_LIST) + (size_t)LAYER * NE * ECAP;
    int* te = (int*)(P.ws + WS_TE) + (size_t)LAYER * T * 4; int* tp = (int*)(P.ws + WS_TP) + (size_t)LAYER * T * 4; float* tg = (float*)(P.ws + WS_TG) + (size_t)LAYER * T * 4;
    const int i = F.lane & 31, h = F.lane >> 5, w = F.wave;
    LAS unsigned char* XS = F.lds + w * 8704;
    LAS unsigned char* FS = F.lds + 69632 + w * 4608;
    LAS float* part = (LAS float*)XS;
    LAS float* ssum = (LAS float*)(F.lds + 106496);
    LAS float* logit = (LAS float*)(F.lds + 107520);
    LAS int* lcnt = (LAS int*)(F.lds + 111744);
    LAS int* gbase = lcnt + 32;
    LAS int* rec_e = (LAS int*)(F.lds + 112128);
    LAS int* rec_l = rec_e + 512; LAS float* rec_g = (LAS float*)(rec_l + 512);
    LAS float* avec = (LAS float*)(F.lds + 118784);
    LAS float* svec = avec + 1024;
    if (F.tid < 32) lcnt[F.tid] = 0;
    const float rbias = P.router_b[LAYER * 32 + (F.tid & 31)];
    bf16x8 bh[8], bl[8];
#pragma unroll
    for (int ks = 0; ks < 8; ++ks) { bh[ks] = *(const bf16x8*)(rwh + (size_t)i * 1024 + 128 * w + 16 * ks + 8 * h); bl[ks] = *(const bf16x8*)(rwl + (size_t)i * 1024 + 128 * w + 16 * ks + 8 * h); }
    const int lc = F.lane & 15, lr = F.lane >> 4;
    u32x4 raw[8];
    int tile = F.bid, ti = 0;
    if (tile < NT) {
#pragma unroll
        for (int j = 0; j < 8; ++j) raw[j] = *(const u32x4*)(X + (size_t)(tile * 32 + 4 * j + lr) * 1024 + 128 * w + 8 * lc); }
    for (; tile < NT; tile += F.G, ++ti) {
        const int row = tile * 32 + i;
        const int mr = LAYER == 0 ? mod_row(tile * 32) : (tile * 32) / LSEQ;
        const float* md = mod + (size_t)mr * 6144;
#pragma unroll
        for (int j = 0; j < 8; ++j) *(LAS u32x4*)(XS + (4 * j + lr) * 272 + 16 * lc) = raw[j];
        const int k2 = 2 * F.tid; const f32x2 mg = *(const f32x2*)(P.norm_ffn + LAYER * 1024 + k2), msc = *(const f32x2*)(md + 4096 + k2), msh = *(const f32x2*)(md + 3072 + k2);
        if (tile + F.G < NT) {
#pragma unroll
            for (int j = 0; j < 8; ++j) raw[j] = *(const u32x4*)(X + (size_t)((tile + F.G) * 32 + 4 * j + lr) * 1024 + 128 * w + 8 * lc); }
        asm volatile("s_waitcnt lgkmcnt(0)" ::: "memory");
        const LAS unsigned char* xfr = XS + i * 272 + 16 * h;
        float ss = 0.f;
#pragma unroll
        for (int ks = 0; ks < 8; ++ks) { const u32x4 xw = *(const LAS u32x4*)(xfr + 32 * ks);
            const float a0 = bf_lo(xw.x), a1 = bf_hi(xw.x), a2 = bf_lo(xw.y), a3 = bf_hi(xw.y), a4 = bf_lo(xw.z), a5 = bf_hi(xw.z), a6 = bf_lo(xw.w), a7 = bf_hi(xw.w);
            ss += ((a0 * a0 + a1 * a1) + (a2 * a2 + a3 * a3)) + ((a4 * a4 + a5 * a5) + (a6 * a6 + a7 * a7)); }
        { const auto r_ = __builtin_amdgcn_permlane32_swap(__float_as_uint(ss), __float_as_uint(ss), false, false); ss = __uint_as_float(r_[0]) + __uint_as_float(r_[1]); }
        if (h == 0) ssum[w * 32 + i] = ss;
        *(LAS f32x2*)(avec + k2) = mg * (msc + 1.0f); *(LAS f32x2*)(svec + k2) = msh;
        __syncthreads();
        float tot = 0.f;
#pragma unroll
        for (int j = 0; j < 8; ++j) tot += ssum[j * 32 + i];
        const float rstd = rsqrtf(tot * (1.0f / 1024.0f) + NORM_EPS);
        f32x16 acc = {};
#pragma unroll
        for (int ks = 0; ks < 8; ++ks) {
            const int k = 128 * w + 16 * ks + 8 * h;
            const u32x4 xw = *(const LAS u32x4*)(xfr + 32 * ks);
            const f32x4 xa = (f32x4){bf_lo(xw.x), bf_hi(xw.x), bf_lo(xw.y), bf_hi(xw.y)}, xb = (f32x4){bf_lo(xw.z), bf_hi(xw.z), bf_lo(xw.w), bf_hi(xw.w)};
            const f32x4 aa = *(const LAS f32x4*)(avec + k), ab = *(const LAS f32x4*)(avec + k + 4), sha = *(const LAS f32x4*)(svec + k), shb = *(const LAS f32x4*)(svec + k + 4);
            const f32x4 fa = (xa * rstd) * aa + sha, fb4 = (xb * rstd) * ab + shb;
            u32x4 hw; hw.x = cvt_pk_bf16(fa[0], fa[1]); hw.y = cvt_pk_bf16(fa[2], fa[3]); hw.z = cvt_pk_bf16(fb4[0], fb4[1]); hw.w = cvt_pk_bf16(fb4[2], fb4[3]);
            u32x4 lw; lw.x = cvt_pk_bf16(fa[0] - bf_lo(hw.x), fa[1] - bf_hi(hw.x)); lw.y = cvt_pk_bf16(fa[2] - bf_lo(hw.y), fa[3] - bf_hi(hw.y));
            lw.z = cvt_pk_bf16(fb4[0] - bf_lo(hw.z), fb4[1] - bf_hi(hw.z)); lw.w = cvt_pk_bf16(fb4[2] - bf_lo(hw.w), fb4[3] - bf_hi(hw.w));
            { const f32x4 qa = fa * F8_SX, qb = fb4 * F8_SX; u32x2 q8; q8.x = pk_fp8x4(qa[0], qa[1], qa[2], qa[3]); q8.y = pk_fp8x4(qb[0], qb[1], qb[2], qb[3]); *(LAS u32x2*)(FS + i * 144 + 16 * ks + 8 * h) = q8; }
            const bf16x8 ah = *reinterpret_cast<bf16x8*>(&hw), alo = *reinterpret_cast<bf16x8*>(&lw);
            acc = __builtin_amdgcn_mfma_f32_32x32x16_bf16(ah, bh[ks], acc, 0, 0, 0);
            acc = __builtin_amdgcn_mfma_f32_32x32x16_bf16(ah, bl[ks], acc, 0, 0, 0);
            acc = __builtin_amdgcn_mfma_f32_32x32x16_bf16(alo, bh[ks], acc, 0, 0, 0);
        }
        asm volatile("s_waitcnt lgkmcnt(0)" ::: "memory");
#pragma unroll
        for (int t = 0; t < 4; ++t) { const int q = F.lane + 64 * t, fr_ = q >> 3, ch = q & 7;
            *(u32x4*)(fb + (size_t)(tile * 32 + fr_) * 1024 + 128 * w + 16 * ch) = *(const LAS u32x4*)(FS + fr_ * 144 + 16 * ch); }
#pragma unroll
        for (int r = 0; r < 16; ++r) { const int tok = (r & 3) + 8 * (r >> 2) + 4 * h; part[tok * 33 + i] = acc[r]; }
        __syncthreads();
#pragma unroll
        for (int q = 0; q < 2; ++q) { const int idx = F.tid + 512 * q, tok = idx >> 5, e = idx & 31; float sacc = 0.f;
#pragma unroll
            for (int j = 0; j < 8; ++j) sacc += ((const LAS float*)(F.lds + j * 8704))[tok * 33 + e];
            logit[tok * 33 + e] = sacc + rbias; }
        __syncthreads();
        {
            const int tok = 4 * w + (F.lane >> 4), rr = F.lane & 15;
            float v0 = logit[tok * 33 + rr], v1 = logit[tok * 33 + rr + 16]; float bv[4]; int bi[4];
#define RT_STEP(CTRL) do { const float ov = __int_as_float(__builtin_amdgcn_update_dpp(0, __float_as_int(cv), (CTRL), 0xF, 0xF, false)); const int oi = __builtin_amdgcn_update_dpp(0, ci, (CTRL), 0xF, 0xF, false); \
                const bool take = (ov > cv) || (ov == cv && oi < ci); cv = take ? ov : cv; ci = take ? oi : ci; } while (0)
#pragma unroll
            for (int rnd = 0; rnd < 4; ++rnd) {
                float cv = v0; int ci = rr; if (v1 > cv) { cv = v1; ci = rr + 16; }
                RT_STEP(0x121); RT_STEP(0x122); RT_STEP(0x124); RT_STEP(0x128);
                bv[rnd] = cv; bi[rnd] = ci; if (ci == rr) v0 = -3.0e38f; if (ci == rr + 16) v1 = -3.0e38f;
            }
#undef RT_STEP
            if (rr == 0) {
                const int l0 = atomicAdd((int*)(lcnt + bi[0]), 1), l1 = atomicAdd((int*)(lcnt + bi[1]), 1), l2 = atomicAdd((int*)(lcnt + bi[2]), 1), l3 = atomicAdd((int*)(lcnt + bi[3]), 1);
                const float e1 = __expf(bv[1] - bv[0]), e2 = __expf(bv[2] - bv[0]), e3 = __expf(bv[3] - bv[0]), inv = 1.0f / (1.0f + e1 + e2 + e3);
                const int o = (ti * 32 + tok) * 4;
                rec_e[o] = bi[0]; rec_e[o + 1] = bi[1]; rec_e[o + 2] = bi[2]; rec_e[o + 3] = bi[3]; rec_l[o] = l0; rec_l[o + 1] = l1; rec_l[o + 2] = l2; rec_l[o + 3] = l3;
                rec_g[o] = inv; rec_g[o + 1] = e1 * inv; rec_g[o + 2] = e2 * inv; rec_g[o + 3] = e3 * inv;
            }
        }
        __syncthreads();
    }
    __syncthreads();
    if (F.tid < 32) { const int c = lcnt[F.tid]; gbase[F.tid] = c ? __hip_atomic_fetch_add(cnt + F.tid * 64, c, __ATOMIC_RELAXED, __HIP_MEMORY_SCOPE_AGENT) : 0; }
    __syncthreads();
    if (F.tid < ti * 32) {
        const int tl = F.tid >> 5, r = (F.bid + tl * F.G) * 32 + (F.tid & 31), o = F.tid * 4;
        const int i0 = rec_e[o], i1 = rec_e[o + 1], i2 = rec_e[o + 2], i3 = rec_e[o + 3];
        const int p0 = gbase[i0] + rec_l[o], p1 = gbase[i1] + rec_l[o + 1], p2 = gbase[i2] + rec_l[o + 2], p3 = gbase[i3] + rec_l[o + 3];
        list[(size_t)i0 * ECAP + p0] = r; list[(size_t)i1 * ECAP + p1] = r; list[(size_t)i2 * ECAP + p2] = r; list[(size_t)i3 * ECAP + p3] = r;
        *(int4*)(te + (size_t)r * 4) = make_int4(i0, i1, i2, i3); *(int4*)(tp + (size_t)r * 4) = make_int4(p0, p1, p2, p3);
        *(float4*)(tg + (size_t)r * 4) = make_float4(rec_g[o], rec_g[o + 1], rec_g[o + 2], rec_g[o + 3]);
    }
    __syncthreads();
}

__device__ __forceinline__ void moe_prefix(const Params& P, const Ctx& F, int layer, LAS int* tbl) {
    const int* cnt = (const int*)(P.ws + WS_CNT + layer * 8192);
    __syncthreads();
    if (F.tid < 32) tbl[33 + F.tid] = ld_agent(cnt + F.tid * 64);
    __syncthreads();
    if (F.tid < 32) { int a = 0, tot = 0;
#pragma unroll
        for (int j = 0; j < 32; ++j) { const int c = (tbl[33 + j] + 255) & ~255; a += (j < F.tid) ? c : 0; tot += c; }
        tbl[F.tid] = a; tbl[66 + F.tid] = a >> 8; if (F.tid == 0) { tbl[32] = tot; tbl[98] = tot >> 8; } }
    __syncthreads();
}

__device__ __forceinline__ void acc_y16(float (&y)[16], const u32x4 w, float gs) {
#pragma unroll
    for (int q = 0; q < 4; ++q) { const f32x2 lo = __builtin_amdgcn_cvt_pk_f32_fp8((int)w[q], false), hi = __builtin_amdgcn_cvt_pk_f32_fp8((int)w[q], true);
        y[4 * q + 0] = fmaf(lo.x, gs, y[4 * q + 0]); y[4 * q + 1] = fmaf(lo.y, gs, y[4 * q + 1]); y[4 * q + 2] = fmaf(hi.x, gs, y[4 * q + 2]); y[4 * q + 3] = fmaf(hi.y, gs, y[4 * q + 3]); }
}
template <int LAYER> __device__ __forceinline__ void combine_phase(const Params& P, const Ctx& F, LAS int* tbl) {
    constexpr int NR = LAYER == 0 ? T : TL;
    const float* mod = (const float*)(P.ws + WS_MOD); const bf16_t* xin = (const bf16_t*)(P.ws + (LAYER == 0 ? WS_X1 : WS_X3C)); const unsigned char* yb = P.ws + WS_YB;
    const int* te = (const int*)(P.ws + WS_TE) + (size_t)LAYER * T * 4; const int* tp = (const int*)(P.ws + WS_TP) + (size_t)LAYER * T * 4; const float* tg = (const float*)(P.ws + WS_TG) + (size_t)LAYER * T * 4;
    bf16_t* x2c = (bf16_t*)(P.ws + WS_X2C); unsigned char* hb = P.ws + WS_HBUF;
    const int nwaves = F.G * 8, rpw = (NR + nwaves - 1) / nwaves, col = 16 * F.lane;
    const int rbeg = (F.bid * 8 + F.wave) * rpw, rend = (rbeg + rpw < NR) ? rbeg + rpw : NR;
    if (rbeg >= rend) return;
    f32x4 g2v[4], nmv[4], scv[4], shv[4]; int cur_mr = -1;
    int my[2], myp[2]; float myg[2]; u32x4 xw[2][2];
#define CB_META(R0) do { _Pragma("unroll") for (int q = 0; q < 2; ++q) { const int r_ = ((R0) + q < rend) ? (R0) + q : (R0); \
        my[q] = (F.lane < 4) ? te[(size_t)r_ * 4 + F.lane] : 0; myp[q] = (F.lane < 4) ? tp[(size_t)r_ * 4 + F.lane] : 0; myg[q] = (F.lane < 4) ? tg[(size_t)r_ * 4 + F.lane] : 0.f; \
        _Pragma("unroll") for (int j = 0; j < 2; ++j) xw[q][j] = *(const u32x4*)(xin + (size_t)r_ * 1024 + col + 8 * j); } } while (0)
    CB_META(rbeg);
    for (int r0 = rbeg; r0 < rend; r0 += 2) {
        const bool ok1 = r0 + 1 < rend;
        u32x4 w[2][4]; float gk[2][4]; u32x4 xc[2][2];
#pragma unroll
        for (int q = 0; q < 2; ++q) {
#pragma unroll
            for (int k = 0; k < 4; ++k) { const int e = __builtin_amdgcn_readlane(my[q], k), pos = __builtin_amdgcn_readlane(myp[q], k);
                gk[q][k] = __int_as_float(__builtin_amdgcn_readlane(__float_as_int(myg[q]), k)) * (1.0f / F8_SY); w[q][k] = *(const u32x4*)(yb + (size_t)(tbl[e] + pos) * 1024 + col); }
            xc[q][0] = xw[q][0]; xc[q][1] = xw[q][1]; }
        if (r0 + 2 < rend) CB_META(r0 + 2);
#pragma unroll
        for (int q = 0; q < 2; ++q) {
            if (q == 1 && !ok1) break;
            const int r = r0 + q;
            int mr; int b = 0, p = 0;
            if (LAYER == 0) { b = r / TBR; p = r - b * TBR; mr = p < CTXL ? 8 : b; } else mr = r / LSEQ;
            if (mr != cur_mr) { cur_mr = mr;
                const float* md0 = mod + (size_t)(LAYER * 9 + mr) * 6144; const float* md1 = mod + (size_t)(9 + mr) * 6144;
#pragma unroll
                for (int j = 0; j < 4; ++j) { g2v[j] = *(const f32x4*)(md0 + 5120 + col + 4 * j);
                    if (LAYER == 0) { nmv[j] = *(const f32x4*)(P.norm_mix + 1024 + col + 4 * j); scv[j] = *(const f32x4*)(md1 + 1024 + col + 4 * j) + 1.0f; shv[j] = *(const f32x4*)(md1 + col + 4 * j); } } }
            float y[16];
#pragma unroll
            for (int j = 0; j < 16; ++j) y[j] = 0.f;
#pragma unroll
            for (int k = 0; k < 4; ++k) acc_y16(y, w[q][k], gk[q][k]);
            f32x4 xv[4];
#pragma unroll
            for (int j = 0; j < 2; ++j) { const u32x4 t = xc[q][j]; xv[2 * j] = (f32x4){bf_lo(t.x), bf_hi(t.x), bf_lo(t.y), bf_hi(t.y)}; xv[2 * j + 1] = (f32x4){bf_lo(t.z), bf_hi(t.z), bf_lo(t.w), bf_hi(t.w)}; }
            if (LAYER == 0) {
                f32x4 v[4]; float ss = 0.f;
#pragma unroll
                for (int j = 0; j < 4; ++j) { v[j] = xv[j] + g2v[j] * (f32x4){y[4 * j], y[4 * j + 1], y[4 * j + 2], y[4 * j + 3]}; ss += (v[j][0] * v[j][0] + v[j][1] * v[j][1]) + (v[j][2] * v[j][2] + v[j][3] * v[j][3]); }
                if (p >= CTXL) {
#pragma unroll
                    for (int j = 0; j < 2; ++j) { u32x4 o; o.x = cvt_pk_bf16(v[2 * j][0], v[2 * j][1]); o.y = cvt_pk_bf16(v[2 * j][2], v[2 * j][3]); o.z = cvt_pk_bf16(v[2 * j + 1][0], v[2 * j + 1][1]); o.w = cvt_pk_bf16(v[2 * j + 1][2], v[2 * j + 1][3]);
                        *(u32x4*)(x2c + ((size_t)b * LSEQ + p - CTXL) * 1024 + col + 8 * j) = o; } }
                ss = wave_sum(ss); const float rstd = rsqrtf(ss * (1.0f / 1024.0f) + NORM_EPS) * F8_SX;
                u32x4 o;
#pragma unroll
                for (int j = 0; j < 4; ++j) { const f32x4 hh = (v[j] * rstd) * nmv[j] * scv[j] + shv[j] * F8_SX; o[j] = pk_fp8x4(hh[0], hh[1], hh[2], hh[3]); }
                *(u32x4*)(hb + (size_t)r * 1024 + col) = o;
            } else {
#pragma unroll
                for (int j = 0; j < 4; ++j) *(f32x4*)(P.out + (size_t)r * 1024 + col + 4 * j) = xv[j] + g2v[j] * (f32x4){y[4 * j], y[4 * j + 1], y[4 * j + 2], y[4 * j + 3]};
            }
        }
    }
#undef CB_META
}

constexpr int NPH = 16;
__global__ void __launch_bounds__(NTHREADS, 2) mk_fwd(Params P) {
    extern __shared__ __attribute__((aligned(16))) unsigned char lds_raw[];
    Ctx F; F.lds = (LAS unsigned char*)lds_raw; F.tid = threadIdx.x; F.lane = F.tid & 63; F.wave = __builtin_amdgcn_readfirstlane(F.tid >> 6); F.G = gridDim.x; F.bid = blockIdx.x;
    LAS unsigned* misc = (LAS unsigned*)(F.lds + MISC_OFF);
    LAS int* tbl = (LAS int*)(F.lds + MISC_OFF + 64);
    if (F.tid < 4) misc[F.tid] = 0u;
    __syncthreads();
    const int lo = P.ph_lo, hi = P.ph_hi;
    XcdBarrier bar; bar.bar = (unsigned*)(P.ws + WS_BAR); bar.x = 0; bar.st = (volatile LAS unsigned*)misc;
    if (hi - lo > 1) bar = xcd_barrier_post((unsigned*)(P.ws + WS_BAR), (volatile LAS unsigned*)misc);
#define IN(k) (lo <= (k) && (k) < hi)
#define SEAM(k) do { if (IN(k) && IN((k) + 1)) xcd_barrier(bar); } while (0)
    unsigned char* ws = P.ws;
    const float* mod = (const float*)(ws + WS_MOD);

    LAS int* rlbuf = (LAS int*)(F.lds + RL_OFF);
    if (IN(0)) { ada_phase(P, F); cvt_phase(P, F); } SEAM(0);
    if (IN(1)) { norm0_phase(P, F); } SEAM(1);
    if (IN(2)) {
        pg8::StaticOrder S; S.init(ws + WS_HBUF, ws + WS_WIN, T, 4096, 512, F.G, F.bid);
        pg8::EpiGeluV E{(bf16_t*)(ws + WS_UV), P.gm_b_in, (float*)(ws + WS_VSS)};
        pg8::gemm_phase<true, F8_EW, F8_EX, false>(F.lds, rlbuf, 512, (size_t)128 * 1024, S, E, fill_done(P, 2), fill_long(F, (T / 256) * 16, F.G));
        tail_fill(P, F, 0, 2, (T / 256) * 16, F.G);
    } SEAM(2);
    if (IN(3)) { sgate_phase(P, F); } SEAM(3);
    if (IN(4)) {
        const int Gg = (F.G >= 256) ? 144 : F.G;
        if (F.bid < Gg) { pg8::StaticOrder S; S.init(ws + WS_TBUF, ws + WS_WOUT, T, 1024, 2048, Gg, F.bid);
            pg8::EpiResid<0> E{P.x, P.ctx, nullptr, mod, (bf16_t*)(ws + WS_X1)};
            pg8::gemm_phase<false, 0, 0, false>(F.lds, rlbuf, 2048, (size_t)128 * 2048 * 2, S, E, fill_done(P, 4), fill_long(F, (T / 256) * 4, Gg)); }
        tail_fill(P, F, 0, 4, (T / 256) * 4, Gg);
    } SEAM(4);
    if (IN(5)) { route_phase<0>(P, F); cvt_fill(P, F, 0, nullptr, -1); } SEAM(5);
    if (IN(6)) {
        moe_prefix(P, F, 0, tbl);
        const int Gg = (F.G >= 4 * MOE_CONV_WGS) ? F.G - MOE_CONV_WGS : F.G;
        if (F.bid < Gg) { MoeOrder S{(const char*)(ws + WS_FBUF), (const char*)(ws + WS_WGU), tbl + 66, tbl + 33, (const int*)(ws + WS_LIST), tbl[98], 8, Gg, F.bid, (size_t)256 * 1024, (size_t)2048 * 1024, (size_t)128 * 1024};
            pg8::EpiSwiglu E{ws + WS_ACT, P.b_gu};
            pg8::gemm_phase<true, F8_EW, F8_EX, true>(F.lds, rlbuf, 512, (size_t)1024 * 1024, S, E, fill_done(P, 6), fill_long(F, tbl[98] * 8, Gg)); }
        tail_fill(P, F, 1, 6, tbl[98] * 8, Gg);
    } SEAM(6);
    if (IN(7)) {
        moe_prefix(P, F, 0, tbl);
        const int Gg = (F.G >= 4 * MOE_CONV_WGS) ? F.G - MOE_CONV_WGS : F.G;
        if (F.bid < Gg) { MoeOrder S{(const char*)(ws + WS_ACT), (const char*)(ws + WS_WDN), tbl + 66, tbl + 33, nullptr, tbl[98], 4, Gg, F.bid, (size_t)256 * 1024, (size_t)1024 * 1024, (size_t)256 * 1024};
            pg8::EpiFp8 E{ws + WS_YB, P.b_dn};
            pg8::gemm_phase<true, F8_EW, F8_EA, false>(F.lds, rlbuf, 512, (size_t)0, S, E, fill_done(P, 7), fill_long(F, tbl[98] * 4, Gg)); }
        tail_fill(P, F, 1, 7, tbl[98] * 4, Gg);
    } SEAM(7);
    if (IN(8)) { moe_prefix(P, F, 0, tbl); combine_phase<0>(P, F, tbl); } SEAM(8);
    if (IN(9)) {
        const int Gg = (F.G >= 256) ? 200 : F.G;
        if (F.bid < Gg) { pg8::QkvOrder S{(const char*)(ws + WS_HBUF), (const char*)(ws + WS_WQKV), Gg, F.bid, (size_t)256 * 1024};
            pg8::EpiQKV E{(bf16_t*)(ws + WS_QB), (bf16_t*)(ws + WS_KB), (bf16_t*)(ws + WS_VB), P.at_q_gain, P.at_k_gain, (LAS float*)(F.lds + QKP_OFF)};
            pg8::gemm_phase<true, F8_EW, F8_EX, false>(F.lds, rlbuf, 512, (size_t)128 * 1024, S, E, fill_done(P, 9), fill_long(F, 400, Gg)); }
        tail_fill(P, F, 1, 9, 400, Gg);
    } SEAM(9);
    if (IN(10)) {
        const unsigned char* Qb = ws + WS_QB; const unsigned char* Kb = ws + WS_KB; const unsigned char* Vb = ws + WS_VB; unsigned char* Ob = ws + WS_OB;
        for (int u = F.bid; u < NB * 8 * 8; u += F.G) {
            const int b = u >> 6, h = (u >> 3) & 7, qb = u & 7;
            const size_t qo = (((size_t)b * 8 + h) * LSEQ + qb * 256) * 128, ko = ((size_t)b * 2 + (h >> 2)) * TBR * 128, oo = ((size_t)b * LSEQ + qb * 256) * 1024 + h * 128;
            att::attn_dense_body(Qb + qo, Kb + ko, Vb + ko, Ob + oo, TBR, (char*)lds_raw);
        }
    } SEAM(10);
    if (IN(11)) {
        pg8::StaticOrder S; S.init(ws + WS_OB, ws + WS_WO, TL, 1024, 512, F.G, F.bid);
        pg8::EpiResid<1> E{nullptr, nullptr, (const bf16_t*)(ws + WS_X2C), mod, (bf16_t*)(ws + WS_X3C)};
        pg8::gemm_phase<true, F8_EW, 0x7b7b7b7b, false>(F.lds, rlbuf, 512, (size_t)128 * 1024, S, E);
    } SEAM(11);
    if (IN(12)) { route_phase<1>(P, F); cvt_fill(P, F, 1, nullptr, -1); } SEAM(12);
    if (IN(13)) {
        moe_prefix(P, F, 1, tbl);
        MoeOrder S{(const char*)(ws + WS_FBUF), (const char*)(ws + WS_WGU) + (size_t)32 * 2048 * 1024, tbl + 66, tbl + 33, (const int*)(ws + WS_LIST) + (size_t)NE * ECAP, tbl[98], 8, F.G, F.bid, (size_t)256 * 1024, (size_t)2048 * 1024, (size_t)128 * 1024};
        pg8::EpiSwiglu E{ws + WS_ACT, P.b_gu + (size_t)32 * 2048};
        pg8::gemm_phase<true, F8_EW, F8_EX, true>(F.lds, rlbuf, 512, (size_t)1024 * 1024, S, E);
    } SEAM(13);
    if (IN(14)) {
        moe_prefix(P, F, 1, tbl);
        MoeOrder S{(const char*)(ws + WS_ACT), (const char*)(ws + WS_WDN) + (size_t)32 * 1024 * 1024, tbl + 66, tbl + 33, nullptr, tbl[98], 4, F.G, F.bid, (size_t)256 * 1024, (size_t)1024 * 1024, (size_t)256 * 1024};
        pg8::EpiFp8 E{ws + WS_YB, P.b_dn + (size_t)32 * 1024};
        pg8::gemm_phase<true, F8_EW, F8_EA, false>(F.lds, rlbuf, 512, (size_t)0, S, E);
    } SEAM(14);
    if (IN(15)) { moe_prefix(P, F, 1, tbl); combine_phase<1>(P, F, tbl); }
#undef IN
#undef SEAM
}

extern "C" void kernel_launch(void* const* d_in, const int* in_sizes, int n_in, void* d_out, int out_size, void* d_ws, size_t ws_size, hipStream_t stream) {
    static int grid = 0;
    if (grid == 0) {
        if (n_in != 24 || in_sizes[0] != NB * LSEQ * DM || out_size != NB * LSEQ * DM || ws_size < WS_END) {
            fprintf(stderr, "kernel_launch: shape / workspace mismatch (n_in %d, in0 %d, out %d, ws %zu, need %zu); nothing launched\n", n_in, n_in > 0 ? in_sizes[0] : -1, out_size, ws_size, (size_t)WS_END); grid = -1; return; }
        int dev = 0, cus = 0, per_cu = 0;
        if (hipGetDevice(&dev) != hipSuccess || hipDeviceGetAttribute(&cus, hipDeviceAttributeMultiprocessorCount, dev) != hipSuccess) { grid = -1; return; }
        if (hipFuncSetAttribute((const void*)mk_fwd, hipFuncAttributeMaxDynamicSharedMemorySize, LDS_BYTES) != hipSuccess) { fprintf(stderr, "kernel_launch: hipFuncSetAttribute failed\n"); grid = -1; return; }
        if (hipOccupancyMaxActiveBlocksPerMultiprocessor(&per_cu, (const void*)mk_fwd, NTHREADS, LDS_BYTES) != hipSuccess || per_cu < 1) { fprintf(stderr, "kernel_launch: occupancy query reports %d\n", per_cu); (void)hipGetLastError(); }
        grid = cus;
    }
    if (grid < 0) return;
    if (hipMemsetAsync((char*)d_ws, 0, WS_ZERO_BYTES, stream) != hipSuccess) return;
    Params p{};
    const float** pf = (const float**)&p;
    for (int i = 0; i < 24; ++i) pf[i] = (const float*)d_in[i];
    p.out = (float*)d_out; p.ws = (unsigned char*)d_ws;
#if MK_N_LAUNCHES == 1
    p.ph_lo = 0; p.ph_hi = NPH;
    hipLaunchKernelGGL(mk_fwd, dim3(grid), dim3(NTHREADS), LDS_BYTES, stream, p);
#else
    for (int ph = 0; ph < NPH; ++ph) { p.ph_lo = ph; p.ph_hi = ph + 1; hipLaunchKernelGGL(mk_fwd, dim3(grid), dim3(NTHREADS), LDS_BYTES, stream, p);
        if ((MK_REPEAT_MASK >> ph) & 1u) hipLaunchKernelGGL(mk_fwd, dim3(grid), dim3(NTHREADS), LDS_BYTES, stream, p); }
#endif
    const hipError_t le = hipPeekAtLastError();
    if (le != hipSuccess) fprintf(stderr, "kernel_launch: launch failed: %s\n", hipGetErrorName(le));
}
```
